# Optimizing an MI355X kernel written in HIP

```python
import math
import jax, jax.numpy as jnp
from jax import lax
import numpy as np

D_MODEL = 2048
BATCH = 4
SEQ = 4096
DEPTH = 1
DEC_BATCH = 32
DEC_SEQ = 4
PAST_LEN = 16384
PAGE_SIZE = 128

MIX_WIDTH = D_MODEL
GLA_HEADS = 4
GLA_DV = (MIX_WIDTH // 2) // GLA_HEADS
GLA_DK = GLA_DV // 2
GLA_GATE_RANK = 16
GLA_TAU = 16.0
GLA_CHUNK = 64
GLA_QK_W = GLA_HEADS * GLA_DK
GLA_V_W = GLA_HEADS * GLA_DV
SWA_HEADS = 8
SWA_HD = (MIX_WIDTH // 2) // SWA_HEADS
SWA_W = SWA_HEADS * SWA_HD
SWA_PATTERNS = ((128, 1), (512, 4), (2048, 16))
SWA_MAX_WINDOW = 2048
D_FF = 5632
CONV_W = 3
EPS = 1e-6

IN_SIZES = (GLA_QK_W, GLA_QK_W, GLA_V_W, GLA_V_W, GLA_GATE_RANK, SWA_W, SWA_W, SWA_W)
IN_COLS = sum(IN_SIZES)

kernel_name = "hybrid_gla_dilated_swa_convffn_step"

F32 = jnp.float32


def rms_norm(x, g):
    xf = x.astype(F32)
    y = xf * lax.rsqrt(jnp.mean(xf * xf, axis=-1, keepdims=True) + EPS) * g.astype(F32)
    return y.astype(x.dtype)


def alibi_slopes(n):
    return 2.0 ** (-8.0 * jnp.arange(1, n + 1, dtype=F32) / n)


def gla_recurrence(q, k, v, log_a, s0):
    b, t, h, dk = q.shape
    dv = v.shape[-1]
    c = min(GLA_CHUNK, t)
    n = -(-t // c)
    pad = n * c - t
    q, k, v, log_a = [a.astype(F32) for a in (q, k, v, log_a)]
    if pad:
        padw = ((0, 0), (0, pad), (0, 0), (0, 0))
        q, k, v, log_a = [jnp.pad(a, padw) for a in (q, k, v, log_a)]

    def blocks(a):
        return a.reshape(b, n, c, h, a.shape[-1]).transpose(1, 0, 3, 2, 4)

    qc, kc, vc, gc = map(blocks, (q, k, v, log_a))
    cum = jnp.cumsum(gc, axis=3)
    total = cum[:, :, :, -1:, :]
    q_dec = qc * jnp.exp(cum)
    k_dec = kc * jnp.exp(-cum)
    k_to_end = kc * jnp.exp(total - cum)
    causal = jnp.tril(jnp.ones((c, c), dtype=bool))
    attn = jnp.where(causal, jnp.einsum('nbhtd,nbhsd->nbhts', q_dec, k_dec), 0.0)
    o_intra = jnp.einsum('nbhts,nbhsv->nbhtv', attn, vc)

    def step(s, inp):
        qd, kte, vv, tot = inp
        o_inter = jnp.einsum('bhtd,bhdv->bhtv', qd, s)
        s_new = s * jnp.exp(tot[:, :, 0, :])[..., None] + jnp.einsum('bhsd,bhsv->bhdv', kte, vv)
        return s_new, o_inter

    s_fin, o_inter = lax.scan(step, s0.astype(F32), (q_dec, k_to_end, vc, total))
    o = (o_intra + o_inter).transpose(1, 0, 3, 2, 4).reshape(b, n * c, h, dv)[:, :t]
    return o, s_fin


def dilated_branch_prompt(q, k, v, window, dil, slopes):
    b, t, h, hd = q.shape
    n = window // dil
    L = t // dil
    nb = -(-L // n)
    pad = nb * n - L

    def by_residue(a):
        a = a.reshape(b, L, dil, h, hd).transpose(0, 2, 3, 1, 4)
        a = jnp.pad(a, ((0, 0), (0, 0), (0, 0), (0, pad), (0, 0)))
        return a.reshape(b, dil, h, nb, n, hd)

    def with_prev(a):
        prev = jnp.pad(a, ((0, 0), (0, 0), (0, 0), (1, 0), (0, 0), (0, 0)))[:, :, :, :-1]
        return jnp.concatenate([prev, a], axis=4)

    qb = by_residue(q)
    k2 = with_prev(by_residue(k))
    v2 = with_prev(by_residue(v))
    s = jnp.einsum('brhnqd,brhnkd->brhnqk', qb, k2) * (SWA_HD ** -0.5)
    steps = jnp.arange(n)[:, None] + n - jnp.arange(2 * n)[None, :]
    blk = jnp.arange(nb)[:, None, None]
    valid = (steps >= 0) & (steps <= n) & (blk * n + jnp.arange(2 * n)[None, None, :] - n >= 0)
    s = s - slopes[:, None, None, None] * (dil * steps).astype(F32)
    s = jnp.where(valid, s, -jnp.inf)
    lse = jax.nn.logsumexp(s, axis=-1)
    o = jnp.einsum('brhnqk,brhnkd->brhnqd', jnp.exp(s - lse[..., None]), v2)

    def back(a):
        a = a.reshape((b, dil, h, nb * n) + a.shape[5:])[:, :, :, :L]
        a = jnp.moveaxis(a, 3, 1)
        return a.reshape((b, t, h) + a.shape[4:])

    return back(o), back(lse)


def dilated_branch_sample(q, k_all, v_all, window, dil, slopes):
    b, tn, h, hd = q.shape
    w_rows = k_all.shape[1] - tn
    n = window // dil
    steps = jnp.arange(n + 1)
    idx = w_rows + jnp.arange(tn)[:, None] - dil * steps[None, :]
    valid = idx >= 0
    idx = jnp.clip(idx, 0)
    kg = k_all[:, idx]
    vg = v_all[:, idx]
    s = jnp.einsum('bqhd,bqkhd->bhqk', q, kg) * (SWA_HD ** -0.5)
    s = s - slopes[:, None, None] * (dil * steps).astype(F32)
    s = jnp.where(valid, s, -jnp.inf)
    lse = jax.nn.logsumexp(s, axis=-1)
    o = jnp.einsum('bhqk,bqkhd->bqhd', jnp.exp(s - lse[..., None]), vg)
    return o, lse.transpose(0, 2, 1)


def combine_branches(outs, lses):
    w = jax.nn.softmax(jnp.stack(lses), axis=0)
    return jnp.einsum('gbth,gbthd->bthd', w, jnp.stack(outs))


def conv_ffn(x, conv_s0, w_up, w_conv, b_conv, w_down):
    t = x.shape[1]
    u = x @ w_up
    u_ext = jnp.concatenate([conv_s0.astype(u.dtype), u], axis=1)
    c = b_conv
    for j in range(CONV_W):
        c = c + w_conv[j] * u_ext[:, j:j + t]
    a, val = jnp.split(c, 2, axis=-1)
    y = (jax.nn.silu(a) * val) @ w_down
    return y, u_ext[:, t:]


def hybrid_layer(x, gla_s0, conv_s0, swa_past, g_attn_norm, w_in, w_gate_up, b_gate, g_gla_norm, w_out,
                 g_ffn_norm, w_up, w_conv, b_conv, w_down):
    b, t, _ = x.shape
    xn = rms_norm(x, g_attn_norm)
    proj = xn @ w_in
    qa, ka, va, ga, za, qb, kb, vb = jnp.split(proj, list(np.cumsum(IN_SIZES)[:-1]), axis=-1)

    log_a = jax.nn.log_sigmoid((za @ w_gate_up + b_gate).astype(F32)) / GLA_TAU
    o_a, s_a = gla_recurrence(
        qa.reshape(b, t, GLA_HEADS, GLA_DK).astype(F32) * (GLA_DK ** -0.5),
        ka.reshape(b, t, GLA_HEADS, GLA_DK),
        va.reshape(b, t, GLA_HEADS, GLA_DV),
        log_a.reshape(b, t, GLA_HEADS, GLA_DK),
        gla_s0)
    o_a = rms_norm(o_a, g_gla_norm.reshape(GLA_HEADS, GLA_DV)).reshape(b, t, GLA_V_W)
    o_a = (o_a * jax.nn.silu(ga.astype(F32))).astype(x.dtype)

    qh = qb.reshape(b, t, SWA_HEADS, SWA_HD)
    kh = kb.reshape(b, t, SWA_HEADS, SWA_HD)
    vh = vb.reshape(b, t, SWA_HEADS, SWA_HD)
    slopes = alibi_slopes(SWA_HEADS)
    if swa_past is None:
        qf, kf, vf = qh.astype(F32), kh.astype(F32), vh.astype(F32)
        res = [dilated_branch_prompt(qf, kf, vf, w, d, slopes) for (w, d) in SWA_PATTERNS]
        keep = min(SWA_MAX_WINDOW, t)
        k_buf, v_buf = kh[:, t - keep:], vh[:, t - keep:]
    else:
        k_all = jnp.concatenate([swa_past[0].astype(kh.dtype), kh], axis=1)
        v_all = jnp.concatenate([swa_past[1].astype(vh.dtype), vh], axis=1)
        qf, kf, vf = qh.astype(F32), k_all.astype(F32), v_all.astype(F32)
        res = [dilated_branch_sample(qf, kf, vf, w, d, slopes) for (w, d) in SWA_PATTERNS]
        keep = min(SWA_MAX_WINDOW, k_all.shape[1])
        k_buf, v_buf = k_all[:, k_all.shape[1] - keep:], v_all[:, v_all.shape[1] - keep:]
    o_b = combine_branches([r[0] for r in res], [r[1] for r in res]).reshape(b, t, SWA_W).astype(x.dtype)

    h = x + jnp.concatenate([o_a, o_b], axis=-1) @ w_out
    f, conv_new = conv_ffn(rms_norm(h, g_ffn_norm), conv_s0, w_up, w_conv, b_conv, w_down)
    return h + f, s_a, k_buf, v_buf, conv_new


def setup_inputs(seed: int = 0) -> dict:
    key = jax.random.key(seed)
    ks = jax.random.split(key, 20)
    w_past = min(SWA_MAX_WINDOW, PAST_LEN)
    nrm = lambda k, shape: jax.random.normal(k, shape, F32)
    return {
        "x_prompt": nrm(ks[0], (BATCH, SEQ, D_MODEL)),
        "x_sample": nrm(ks[1], (DEC_BATCH, DEC_SEQ, D_MODEL)),
        "state_gla": nrm(ks[2], (DEPTH, DEC_BATCH, GLA_HEADS, GLA_DK, GLA_DV)),
        "cache_swa_k": nrm(ks[3], (DEPTH, DEC_BATCH, w_past, SWA_HEADS, SWA_HD)),
        "cache_swa_v": nrm(ks[4], (DEPTH, DEC_BATCH, w_past, SWA_HEADS, SWA_HD)),
        "state_ffn_conv": nrm(ks[5], (DEPTH, DEC_BATCH, CONV_W - 1, 2 * D_FF)),
        "g_attn_norm": 1.0 + 0.02 * nrm(ks[6], (DEPTH, D_MODEL)),
        "w_in": nrm(ks[7], (DEPTH, D_MODEL, IN_COLS)) * D_MODEL ** -0.5,
        "w_gate_up": nrm(ks[8], (DEPTH, GLA_GATE_RANK, GLA_QK_W)) * GLA_GATE_RANK ** -0.5,
        "b_gate": 0.1 * nrm(ks[9], (DEPTH, GLA_QK_W)),
        "g_gla_norm": 1.0 + 0.02 * nrm(ks[10], (DEPTH, GLA_V_W)),
        "w_out": nrm(ks[11], (DEPTH, MIX_WIDTH, D_MODEL)) * MIX_WIDTH ** -0.5,
        "g_ffn_norm": 1.0 + 0.02 * nrm(ks[12], (DEPTH, D_MODEL)),
        "w_up": nrm(ks[13], (DEPTH, D_MODEL, 2 * D_FF)) * D_MODEL ** -0.5,
        "w_conv": nrm(ks[14], (DEPTH, CONV_W, 2 * D_FF)) * CONV_W ** -0.5,
        "b_conv": 0.02 * nrm(ks[15], (DEPTH, 2 * D_FF)),
        "w_down": nrm(ks[16], (DEPTH, D_FF, D_MODEL)) * D_FF ** -0.5,
        "g_final": 1.0 + 0.02 * nrm(ks[17], (D_MODEL,)),
    }


def reference(x_prompt, x_sample, state_gla, cache_swa_k, cache_swa_v, state_ffn_conv,
              g_attn_norm, w_in, w_gate_up, b_gate, g_gla_norm, w_out,
              g_ffn_norm, w_up, w_conv, b_conv, w_down, g_final):
    yp, ys = x_prompt, x_sample
    gla_p, gla_s, kp, ksm, vp, vsm, cp, csm = [], [], [], [], [], [], [], []
    for l in range(DEPTH):
        params = (g_attn_norm[l], w_in[l], w_gate_up[l], b_gate[l], g_gla_norm[l], w_out[l],
                  g_ffn_norm[l], w_up[l], w_conv[l], b_conv[l], w_down[l])
        gla0 = jnp.zeros((yp.shape[0], GLA_HEADS, GLA_DK, GLA_DV), F32)
        conv0 = jnp.zeros((yp.shape[0], CONV_W - 1, 2 * D_FF), yp.dtype)
        yp, s1, k1, v1, c1 = hybrid_layer(yp, gla0, conv0, None, *params)
        ys, s2, k2, v2, c2 = hybrid_layer(ys, state_gla[l], state_ffn_conv[l],
                                          (cache_swa_k[l], cache_swa_v[l]), *params)
        gla_p.append(s1); gla_s.append(s2)
        kp.append(k1); ksm.append(k2)
        vp.append(v1); vsm.append(v2)
        cp.append(c1); csm.append(c2)
    y_prompt = rms_norm(yp, g_final)
    y_sample = rms_norm(ys, g_final)
    state_gla_prompt = jnp.stack(gla_p)
    state_gla_sample = jnp.stack(gla_s)
    cache_swa_k_prompt = jnp.stack(kp)
    cache_swa_k_sample = jnp.stack(ksm)
    cache_swa_v_prompt = jnp.stack(vp)
    cache_swa_v_sample = jnp.stack(vsm)
    state_ffn_conv_prompt = jnp.stack(cp)
    state_ffn_conv_sample = jnp.stack(csm)
    return (y_prompt, y_sample, state_gla_prompt, state_gla_sample, cache_swa_k_prompt, cache_swa_k_sample,
            cache_swa_v_prompt, cache_swa_v_sample, state_ffn_conv_prompt, state_ffn_conv_sample)
```

```cpp
#include <hip/hip_runtime.h>
#include <hip/hip_cooperative_groups.h>
#include <cstdio>
#include <cstdint>
namespace cg = cooperative_groups;

#ifndef ONE_LAUNCH
#define ONE_LAUNCH 1
#endif

#define LAS __attribute__((address_space(3)))
typedef unsigned short bf16_t;
typedef short bf16x8 __attribute__((ext_vector_type(8)));
typedef short s16x4 __attribute__((ext_vector_type(4)));
typedef float f32x4 __attribute__((ext_vector_type(4)));
typedef float f32x2 __attribute__((ext_vector_type(2)));
typedef unsigned u32x4 __attribute__((ext_vector_type(4)));
typedef unsigned u32x2 __attribute__((ext_vector_type(2)));
typedef __bf16 bf16v2 __attribute__((ext_vector_type(2)));

constexpr int DM = 2048;
constexpr int NTP = 16384, NTS = 128, NTOK = NTP + NTS, MPAD = 16640;
constexpr int SEQ = 4096;
constexpr int NIN = 6400;
constexpr int C_QA = 0, C_KA = 512, C_VA = 1024, C_GA = 2048, C_QB = 3072, C_KB = 4096, C_VB = 5120, C_ZA = 6144;
constexpr int DFF = 5632, NUP = 11264;
constexpr float EPS = 1e-6f;
constexpr int NTHR = 512;
constexpr int LDS_BYTES = 152320;

constexpr size_t O_YP = 0;
constexpr size_t O_YS = O_YP + (size_t)NTP * DM;
constexpr size_t O_SGP = O_YS + (size_t)NTS * DM;
constexpr size_t O_SGS = O_SGP + (size_t)4 * 4 * 128 * 256;
constexpr size_t O_CKP = O_SGS + (size_t)32 * 4 * 128 * 256;
constexpr size_t O_CKS = O_CKP + (size_t)4 * 2048 * 1024;
constexpr size_t O_CVP = O_CKS + (size_t)32 * 2048 * 1024;
constexpr size_t O_CVS = O_CVP + (size_t)4 * 2048 * 1024;
constexpr size_t O_CONVP = O_CVS + (size_t)32 * 2048 * 1024;
constexpr size_t O_CONVS = O_CONVP + (size_t)4 * 2 * NUP;
constexpr size_t O_END = O_CONVS + (size_t)32 * 2 * NUP;

constexpr size_t al256(size_t x) { return (x + 255) & ~(size_t)255; }
constexpr size_t W_WIN = 0;
constexpr size_t W_WOUT = W_WIN + al256((size_t)NIN * DM * 2);
constexpr size_t W_WUP = W_WOUT + al256((size_t)DM * DM * 2);
constexpr size_t W_WDOWN = W_WUP + al256((size_t)NUP * DM * 2);
constexpr size_t W_RSTD1 = W_WDOWN + al256((size_t)DM * DFF * 2);
constexpr size_t W_SS2 = W_RSTD1 + al256((size_t)MPAD * 4);
constexpr size_t W_SS3 = W_SS2 + al256((size_t)MPAD * 4);
constexpr size_t W_CTL = W_SS3 + al256((size_t)MPAD * 4);
constexpr size_t W_CNT = W_CTL + 256;
constexpr size_t W_BAR = W_CNT + 512;
constexpr size_t W_H = W_BAR + 16384;
constexpr size_t W_HB = W_H + al256((size_t)MPAD * DM * 4);
constexpr size_t W_RA = W_HB + al256((size_t)MPAD * DM * 2);
constexpr size_t W_XB = W_RA;
constexpr size_t W_ZA = W_XB + al256((size_t)MPAD * DM * 2);
constexpr size_t W_PROJ = W_ZA + al256((size_t)MPAD * 16 * 4);
constexpr size_t W_OARAW = W_PROJ + al256((size_t)MPAD * NIN * 2);
constexpr size_t W_OB3 = W_OARAW + al256((size_t)MPAD * 1024 * 4);
constexpr size_t W_LSE3 = W_OB3 + al256((size_t)3 * NTP * 1024 * 2);
constexpr size_t W_MIX = W_LSE3 + al256((size_t)3 * NTP * 8 * 4);
constexpr size_t W_QD = W_MIX + al256((size_t)MPAD * DM * 2);
constexpr size_t W_KT = W_QD + al256((size_t)NTP * 512 * 2);
constexpr size_t W_VT = W_KT + al256((size_t)1024 * 128 * 64 * 2);
constexpr size_t W_ET = W_VT + al256((size_t)1024 * 256 * 64 * 2);
constexpr size_t W_OI = W_ET + al256((size_t)1024 * 128 * 4);
constexpr size_t W_KC = W_OI + al256((size_t)NTP * 1024 * 4);
constexpr size_t W_VC = W_KC + al256((size_t)NTP * 1024 * 2);
constexpr size_t W_RA_END = W_VC + al256((size_t)NTP * 1024 * 2);
constexpr size_t W_U = W_RA;
constexpr size_t W_U_END = W_U + al256((size_t)MPAD * NUP * 2);
constexpr size_t W_ACT = W_U_END;
constexpr size_t W_ACT_END = W_ACT + al256((size_t)MPAD * DFF * 2);
constexpr size_t W_END = (W_RA_END > W_ACT_END ? W_RA_END : W_ACT_END);
static_assert(W_END <= ((size_t)1 << 30), "workspace too large");

struct Params {
    const float* in[18];
    float* out;
    unsigned char* ws;
    int ph_lo, ph_hi;
};

__device__ __forceinline__ unsigned pk_bf16(float a, float b) { f32x2 v = {a, b}; bf16v2 r = __builtin_convertvector(v, bf16v2); return __builtin_bit_cast(unsigned, r); }
__device__ __forceinline__ float bf2f(unsigned short b) { return __uint_as_float(((unsigned)b) << 16); }
__device__ __forceinline__ float bflo(unsigned w) { return __uint_as_float(w << 16); }
__device__ __forceinline__ float bfhi(unsigned w) { return __uint_as_float(w & 0xffff0000u); }
__device__ __forceinline__ bf16_t f2bf(float a) { return (bf16_t)(pk_bf16(a, 0.f) & 0xffffu); }
__device__ __forceinline__ s16x4 tr_read(unsigned lds_addr) { s16x4 r; asm volatile("ds_read_b64_tr_b16 %0, %1\n\ts_waitcnt lgkmcnt(0)" : "=&v"(r) : "v"(lds_addr) : "memory"); return r; }
__device__ __forceinline__ float siluf(float x) { return x * __builtin_amdgcn_rcpf(1.f + __expf(-x)); }
__device__ __forceinline__ float logsigmoidf(float z) { return fminf(z, 0.f) - __logf(1.0f + __expf(-fabsf(z))); }

namespace pg8 { __host__ __device__ __forceinline__ int lds_byte(int r, int c); }
#define XB_TMO      128
#define XB_XCNT(j)  (256  + 64 * (j))
#define XB_XSUB(j)  (1280 + 64 * (j))
#define XB_XGEN(j)  (2304 + 64 * (j))
#define XB_TOP      3328
#define XB_TOPGEN   3392
#define XCD_BAR_WORDS 3456
#define XB_SPIN_CAP (1u << 20)
__device__ __forceinline__ unsigned xb_ld(unsigned* p)              { return __hip_atomic_load(p, __ATOMIC_RELAXED, __HIP_MEMORY_SCOPE_AGENT); }
__device__ __forceinline__ unsigned xb_add(unsigned* p, unsigned v) { return __hip_atomic_fetch_add(p, v, __ATOMIC_RELAXED, __HIP_MEMORY_SCOPE_AGENT); }
__device__ __forceinline__ unsigned xb_xcc_id() { return (unsigned)__builtin_amdgcn_s_getreg((3 << 11) | 20) & 0xFu; }
#define XB_SPIN(cond, bar) do { unsigned _sp = 0; while (cond) { __builtin_amdgcn_s_sleep(1); \
    if ((++_sp & 255u) == 0u) { if (xb_ld(&(bar)[XB_TMO])) break; if (_sp > XB_SPIN_CAP) { atomicAdd(&(bar)[XB_TMO], 1u); break; } } } } while (0)
struct XcdBarrier { unsigned* bar; unsigned x; volatile LAS unsigned* st; };
__device__ __forceinline__ XcdBarrier xcd_barrier_post(unsigned* bar, volatile LAS unsigned* st) {
    XcdBarrier b; b.bar = bar; b.x = xb_xcc_id(); b.st = st;
    if (threadIdx.x == 0) (void)xb_add(&bar[XB_XCNT(b.x)], 1u);
    return b;
}
__device__ __forceinline__ void xcd_barrier_complete(unsigned* bar, unsigned x, unsigned& nloc, unsigned& nx) {
    const unsigned G = gridDim.x * gridDim.y * gridDim.z;
    unsigned sum, cnt, mine, sp = 0u;
    for (;;) {
        sum = 0u; cnt = 0u; mine = 0u;
#pragma unroll
        for (unsigned j = 0; j < 16; ++j) { const unsigned c = xb_ld(&bar[XB_XCNT(j)]); sum += c; cnt += (c > 0u) ? 1u : 0u; mine = (j == x) ? c : mine; }
        if (sum == G) break;
        __builtin_amdgcn_s_sleep(1);
        if ((++sp & 255u) == 0u) { if (xb_ld(&bar[XB_TMO])) break; if (sp > XB_SPIN_CAP) { atomicAdd(&bar[XB_TMO], 1u); break; } }
    }
    nloc = mine > 0u ? mine : 1u; nx = cnt > 0u ? cnt : 1u;
}
__device__ __forceinline__ void xcd_barrier(const XcdBarrier& b) {
    asm volatile("s_waitcnt vmcnt(0)" ::: "memory");
    __syncthreads();
    if (threadIdx.x == 0) {
        unsigned* bar = b.bar;
        __builtin_amdgcn_s_waitcnt(0);
        unsigned nloc = b.st[0], nx = b.st[1];
        if (nloc == 0u) { xcd_barrier_complete(bar, b.x, nloc, nx); b.st[0] = nloc; b.st[1] = nx; }
        const unsigned old = xb_add(&bar[XB_XSUB(b.x)], 1u);
        const unsigned gen = old / nloc;
        if (old + 1u == (gen + 1u) * nloc) {
            __builtin_amdgcn_fence(__ATOMIC_RELEASE, "agent");
            asm volatile("s_waitcnt vmcnt(0)" ::: "memory");
            const unsigned og = xb_add(&bar[XB_TOP], 1u);
            const unsigned tg = og / nx;
            if (og + 1u == (tg + 1u) * nx) xb_add(&bar[XB_TOPGEN], 1u);
            else XB_SPIN(xb_ld(&bar[XB_TOPGEN]) == tg, bar);
            __builtin_amdgcn_fence(__ATOMIC_ACQUIRE, "agent");
            xb_add(&bar[XB_XGEN(b.x)], 1u);
            asm volatile("s_waitcnt vmcnt(0)" ::: "memory");
        } else {
            XB_SPIN(xb_ld(&bar[XB_XGEN(b.x)]) == gen, bar);
            __builtin_amdgcn_fence(__ATOMIC_ACQUIRE, "agent");
            asm volatile("s_waitcnt vmcnt(0)" ::: "memory");
        }
    }
    __syncthreads();
}

namespace pg8 {
constexpr int BM = 256, BK = 64, HALF = 128, HTB = HALF * BK * 2, STAGE_BYTES = 8 * HTB, NXCD = 8, WGM = 8;
__host__ __device__ __forceinline__ int lds_byte(int r, int c) { const int st = (r >> 4) * 2 + (c >> 5), rr = r & 15, cc = c & 31, ob = rr * 64 + cc * 2; return st * 1024 + (ob ^ (((ob >> 9) & 1) << 5)); }
__host__ __device__ __forceinline__ void stage_rc(int b, int& R, int& C) { const int st = b / 1024, sb = b % 1024, swz = sb ^ (((sb >> 9) & 1) << 5); R = (st >> 1) * 16 + swz / 64; C = (st & 1) * 32 + (swz % 64) / 2; }
struct Unit { int pm, pn; };
struct Gemm { const bf16_t* A; const bf16_t* Bt; int M, N, K; };
struct StaticOrder {
    int nM, nN, nwg, G, c, ntK, tsplit;
    __host__ __device__ void init(int M, int N, int K, int G_, int c_, int tsplit_ = 1) { nM = M / BM - 1; nN = N / BM; nwg = nM * nN; G = G_; c = c_; ntK = K / BK; tsplit = tsplit_; }
    __host__ __device__ bool next(int i, Unit& u) const {
        const long L = (long)i * G + c; if (L >= nwg + nN * tsplit) return false;
        if (L >= nwg) { const int idx = (int)(L - nwg); u.pm = nM; u.pn = (idx % nN) | ((idx / nN) << 8); return true; }
        int wgid = (int)L; { const int q = nwg / NXCD, r = nwg % NXCD, xcd = wgid % NXCD, off = wgid / NXCD; wgid = (xcd < r ? xcd * (q + 1) : r * (q + 1) + (xcd - r) * q) + off; }
        const int nig = WGM * nN, gid = wgid / nig, fm = gid * WGM, gsz = (nM - fm) < WGM ? (nM - fm) : WGM;
        u.pm = fm + ((wgid % nig) % gsz); u.pn = (wgid % nig) / gsz; return true;
    }
};

template <class Epi, bool KSPLIT = false>
__device__ __forceinline__ void gemm_phase(LAS unsigned char* lds, const Gemm g, const StaticOrder& S, const Epi& E) {
    const int tid = threadIdx.x, wid = __builtin_amdgcn_readfirstlane(tid >> 6), lane = tid & 63, wr = wid >> 2, wc = wid & 3, fr = lane & 15, fq = lane >> 4;
    const int K = g.K;
    unsigned voffA[2], voffB[2];
#pragma unroll
    for (int i = 0; i < 2; ++i) { int R, C; stage_rc(tid * 16 + i * 8192, R, C); voffA[i] = (unsigned)(R * K + C) * 2u; voffB[i] = (unsigned)(tid * 16 + i * 8192); }
    const size_t kstep = (size_t)(BK * 2);
    const size_t hstep = (size_t)HALF * K * 2;
    const size_t tstep = 2 * hstep;
    const size_t kstepB = 16384, hstepB = (size_t)(K / BK) * 16384, tstepB = 2 * hstepB;
    const unsigned ldsw = (unsigned)wid * 1024u;
    const int aoff = lds_byte(wr * 64 + fr, fq * 8), boff = lds_byte(wc * 32 + fr, fq * 8);
#define PG8_SA(b, h) (((b) * 2 + (h)) * HTB)
#define PG8_SB(b, h) ((4 + (b) * 2 + (h)) * HTB)
#define PG8_STAGE(bufoff, gbase, voff) do { _Pragma("unroll") for (int _i = 0; _i < 2; ++_i) \
        __builtin_amdgcn_global_load_lds((const unsigned*)((const char*)(gbase) + (voff)[_i]), (LAS unsigned*)(lds + (bufoff) + ldsw + _i * 8192), 16, 0, 0); } while (0)
#define PG8_LDA(dst, b, h) do { _Pragma("unroll") for (int m = 0; m < 4; ++m) _Pragma("unroll") for (int k = 0; k < 2; ++k) dst[m][k] = *(const LAS bf16x8*)(lds + PG8_SA(b, h) + aoff + m * 2048 + k * 1024); } while (0)
#define PG8_LDB(dst, b, h) do { _Pragma("unroll") for (int n = 0; n < 2; ++n) _Pragma("unroll") for (int k = 0; k < 2; ++k) dst[n][k] = *(const LAS bf16x8*)(lds + PG8_SB(b, h) + boff + n * 2048 + k * 1024); } while (0)
#define PG8_MMA(ai, bj, At, Bt) do { __builtin_amdgcn_s_setprio(1); _Pragma("unroll") for (int m = 0; m < 4; ++m) _Pragma("unroll") for (int n = 0; n < 2; ++n) _Pragma("unroll") for (int k = 0; k < 2; ++k) \
        acc[ai][bj][m][n] = __builtin_amdgcn_mfma_f32_16x16x32_bf16(Bt[n][k], At[m][k], acc[ai][bj][m][n], 0, 0, 0); __builtin_amdgcn_s_setprio(0); } while (0)
#define PG8_WAIT_V(n) asm volatile("s_waitcnt vmcnt(" #n ")" ::: "memory")
#define PG8_WAIT_L(n) asm volatile("s_waitcnt lgkmcnt(" #n ")" ::: "memory")
#define PG8_BAR __builtin_amdgcn_s_barrier()
#define PG8_SCHED __builtin_amdgcn_sched_barrier(0)
    Unit cur, nxt; int ui = 0;
    if (!S.next(0, cur)) return;
    f32x4 acc[2][2][4][2];
#pragma unroll
    for (int a = 0; a < 2; ++a)
#pragma unroll
        for (int b = 0; b < 2; ++b)
#pragma unroll
            for (int m = 0; m < 4; ++m)
#pragma unroll
                for (int n = 0; n < 2; ++n) acc[a][b][m][n] = (f32x4){0.f, 0.f, 0.f, 0.f};
    bf16x8 At[4][2], B0[2][2], B1[2][2];
    const int ntail = S.ntK / S.tsplit;
    const char* cA = (const char*)g.A + (size_t)cur.pm * tstep + (KSPLIT ? (size_t)((cur.pn >> 8) * ntail) * kstep : 0); const char* cB = (const char*)g.Bt + (size_t)(cur.pn & 255) * tstepB + (KSPLIT ? (size_t)((cur.pn >> 8) * ntail) * kstepB : 0);
    PG8_STAGE(PG8_SB(0, 0), cB, voffB); PG8_STAGE(PG8_SA(0, 0), cA, voffA); PG8_STAGE(PG8_SB(0, 1), cB + hstepB, voffB); PG8_STAGE(PG8_SA(0, 1), cA + hstep, voffA);
    if (wr == 1) PG8_BAR;
    PG8_WAIT_V(4); PG8_BAR;
    PG8_STAGE(PG8_SB(1, 0), cB + kstepB, voffB); PG8_STAGE(PG8_SA(1, 0), cA + kstep, voffA); PG8_STAGE(PG8_SB(1, 1), cB + hstepB + kstepB, voffB);
    PG8_WAIT_V(6); PG8_BAR;
    for (;;) {
        const bool has_next = S.next(ui + 1, nxt);
        const char* nA = has_next ? (const char*)g.A + (size_t)nxt.pm * tstep + (KSPLIT ? (size_t)((nxt.pn >> 8) * ntail) * kstep : 0) : cA; const char* nB = has_next ? (const char*)g.Bt + (size_t)(nxt.pn & 255) * tstepB + (KSPLIT ? (size_t)((nxt.pn >> 8) * ntail) * kstepB : 0) : cB;
        const int nt = (KSPLIT && cur.pm == S.nM) ? ntail : K / BK;
        for (int t = 0; t < nt; t += 2) {
            const bool last = (t == nt - 2);
            const char* a1 = cA + (size_t)(t + 1) * kstep;
            const char* a2 = last ? nA : cA + (size_t)(t + 2) * kstep; const char* b2 = last ? nB : cB + (size_t)(t + 2) * kstepB;
            const char* a3 = a2 + kstep; const char* b3 = b2 + kstepB;
            PG8_LDB(B0, 0, 0); PG8_SCHED; PG8_LDA(At, 0, 0); PG8_STAGE(PG8_SA(1, 1), a1 + hstep, voffA);
            PG8_WAIT_L(8); PG8_BAR; PG8_WAIT_L(0); PG8_MMA(0, 0, At, B0); PG8_BAR; PG8_SCHED;
            PG8_LDB(B1, 0, 1); PG8_STAGE(PG8_SB(0, 0), b2, voffB);
            PG8_BAR; PG8_WAIT_L(0); PG8_MMA(0, 1, At, B1); PG8_BAR;
            PG8_LDA(At, 0, 1); PG8_STAGE(PG8_SA(0, 0), a2, voffA);
            PG8_BAR; PG8_WAIT_L(0); PG8_MMA(1, 0, At, B0); PG8_BAR; PG8_SCHED;
            PG8_STAGE(PG8_SB(0, 1), b2 + hstepB, voffB);
            PG8_WAIT_V(6); PG8_BAR; PG8_MMA(1, 1, At, B1); PG8_BAR;
            PG8_LDB(B0, 1, 0); PG8_SCHED; PG8_LDA(At, 1, 0); PG8_STAGE(PG8_SA(0, 1), a2 + hstep, voffA);
            PG8_WAIT_L(8); PG8_BAR; PG8_WAIT_L(0); PG8_MMA(0, 0, At, B0); PG8_BAR; PG8_SCHED;
            PG8_LDB(B1, 1, 1); PG8_STAGE(PG8_SB(1, 0), b3, voffB);
            PG8_BAR; PG8_WAIT_L(0); PG8_MMA(0, 1, At, B1); PG8_BAR;
            PG8_LDA(At, 1, 1); PG8_STAGE(PG8_SA(1, 0), a3, voffA);
            PG8_BAR; PG8_WAIT_L(0); PG8_MMA(1, 0, At, B0); PG8_BAR; PG8_SCHED;
            PG8_STAGE(PG8_SB(1, 1), b3 + hstepB, voffB);
            PG8_WAIT_V(6); PG8_BAR; PG8_MMA(1, 1, At, B1); PG8_BAR;
        }
        { Unit ue; ue.pm = cur.pm; ue.pn = cur.pn & 255; E(acc, ue, wr, wc, fr, fq); }
        if (!has_next) break;
#pragma unroll
        for (int a = 0; a < 2; ++a)
#pragma unroll
            for (int b = 0; b < 2; ++b)
#pragma unroll
                for (int m = 0; m < 4; ++m)
#pragma unroll
                    for (int n = 0; n < 2; ++n) acc[a][b][m][n] = (f32x4){0.f, 0.f, 0.f, 0.f};
        cur = nxt; cA = nA; cB = nB; ++ui;
    }
    PG8_WAIT_V(0);
    if (wr == 0) PG8_BAR;
    PG8_BAR;
#undef PG8_SA
#undef PG8_SB
#undef PG8_STAGE
#undef PG8_LDA
#undef PG8_LDB
#undef PG8_MMA
#undef PG8_WAIT_V
#undef PG8_WAIT_L
#undef PG8_BAR
#undef PG8_SCHED
}
}
using pg8::Unit;

struct EpiIn {
    bf16_t* proj; const float* rstd1; float* za; float* out; bf16_t* kc; bf16_t* vc;
    __device__ __forceinline__ void operator()(const f32x4 (&acc)[2][2][4][2], const Unit& u, int wr, int wc, int fr, int fq) const {
        const int pn = u.pn;
#pragma unroll
        for (int ai = 0; ai < 2; ++ai)
#pragma unroll
            for (int m = 0; m < 4; ++m) {
                const int row = u.pm * 256 + ai * 128 + wr * 64 + m * 16 + fr;
                if (row >= NTOK) continue;
                const float rs = rstd1[row];
                float* kvdst = nullptr;
                if (pn >= 16 && pn < 24) {
                    if (row < NTP) { const int b = row >> 12, t = row & 4095; if (t >= 2048) kvdst = out + (pn >= 20 ? O_CVP : O_CKP) + ((size_t)(b * 2048 + t - 2048)) * 1024; }
                    else { const int s = (row - NTP) >> 2, i = (row - NTP) & 3; kvdst = out + (pn >= 20 ? O_CVS : O_CKS) + ((size_t)(s * 2048 + 2044 + i)) * 1024; }
                }
#pragma unroll
                for (int bj = 0; bj < 2; ++bj)
#pragma unroll
                    for (int n = 0; n < 2; ++n) {
                        const int col = pn * 256 + bj * 128 + wc * 32 + n * 16 + 4 * fq;
                        const f32x4 v = acc[ai][bj][m][n] * rs;
                        u32x2 w; w.x = pk_bf16(v[0], v[1]); w.y = pk_bf16(v[2], v[3]);
                        *(u32x2*)(proj + (size_t)row * NIN + col) = w;
                        if (kvdst) *(f32x4*)(kvdst + (col - (pn >= 20 ? C_VB : C_KB))) = v;
                        if (pn >= 16 && pn < 24 && row < NTP) { const int cc = col - (pn >= 20 ? C_VB : C_KB); *(u32x2*)((pn >= 20 ? vc : kc) + ((size_t)((row >> 12) * 8 + (cc >> 7)) * SEQ + (row & 4095)) * 128 + (cc & 127)) = w; }
                        if (pn == 24 && col < C_ZA + 16) *(f32x4*)(za + (size_t)row * 16 + (col - C_ZA)) = v;
                    }
            }
    }
};
struct EpiOut {
    const float* xp; const float* xs; float* h; bf16_t* hb; float* ss;
    __device__ __forceinline__ void operator()(const f32x4 (&acc)[2][2][4][2], const Unit& u, int wr, int wc, int fr, int fq) const {
#pragma unroll
        for (int ai = 0; ai < 2; ++ai)
#pragma unroll
            for (int m = 0; m < 4; ++m) {
                const int row = u.pm * 256 + ai * 128 + wr * 64 + m * 16 + fr;
                if (row >= NTOK) continue;
                const float* xr = row < NTP ? xp + (size_t)row * DM : xs + (size_t)(row - NTP) * DM;
                float s = 0.f;
#pragma unroll
                for (int bj = 0; bj < 2; ++bj)
#pragma unroll
                    for (int n = 0; n < 2; ++n) {
                        const int col = u.pn * 256 + bj * 128 + wc * 32 + n * 16 + 4 * fq;
                        const f32x4 v = acc[ai][bj][m][n] + *(const f32x4*)(xr + col);
                        *(f32x4*)(h + (size_t)row * DM + col) = v;
                        u32x2 w; w.x = pk_bf16(v[0], v[1]); w.y = pk_bf16(v[2], v[3]);
                        *(u32x2*)(hb + (size_t)row * DM + col) = w;
                        s += v[0] * v[0] + v[1] * v[1] + v[2] * v[2] + v[3] * v[3];
                    }
                s += __shfl_xor(s, 16); s += __shfl_xor(s, 32);
                if (fq == 0) atomicAdd(ss + row, s);
            }
    }
};
template <int CTRL> __device__ __forceinline__ float dppf(float x) { return __builtin_bit_cast(float, __builtin_amdgcn_update_dpp(0, __builtin_bit_cast(int, x), CTRL, 0xf, 0xf, false)); }
struct EpiUp {
    bf16_t* U; bf16_t* act; const float* ss; float* out; const float* wcv; const float* bcv;
    __device__ __forceinline__ void operator()(const f32x4 (&acc)[2][2][4][2], const Unit& u, int wr, int wc, int fr, int fq) const {
        const int pn = u.pn;
#pragma unroll
        for (int ai = 0; ai < 2; ++ai) {
            const int rowb = u.pm * 256 + ai * 128 + wr * 64 + fr;
            if (rowb - fr >= NTOK) continue;
            float rs[4];
#pragma unroll
            for (int m = 0; m < 4; ++m) rs[m] = rsqrtf(ss[rowb + 16 * m] * (1.0f / DM) + EPS);
            const bool sample = rowb >= NTP;
#pragma unroll
            for (int n = 0; n < 2; ++n) {
                const int jl = wc * 32 + n * 16 + 4 * fq, j = pn * 128 + jl;
#pragma unroll
                for (int m = 0; m < 4; ++m) {
                    const int row = rowb + 16 * m;
                    const bool raw = sample || (m == 0 && fr < 2) || (m == 3 && fr >= 14);
                    float* cdst = nullptr;
                    if (!sample) { const int b = row >> 12, t = row & 4095; if (t >= 4094) cdst = out + O_CONVP + (size_t)(b * 2 + (t - 4094)) * NUP; }
                    else { const int s = (row - NTP) >> 2, i = (row - NTP) & 3; if (i >= 2) cdst = out + O_CONVS + (size_t)(s * 2 + (i - 2)) * NUP; }
                    if (raw || cdst) {
                        const f32x4 ua = acc[ai][0][m][n] * rs[m], uv = acc[ai][1][m][n] * rs[m];
                        if (raw) {
                            u32x2 w; w.x = pk_bf16(ua[0], ua[1]); w.y = pk_bf16(ua[2], ua[3]);
                            *(u32x2*)(U + (size_t)row * NUP + pn * 256 + jl) = w;
                            w.x = pk_bf16(uv[0], uv[1]); w.y = pk_bf16(uv[2], uv[3]);
                            *(u32x2*)(U + (size_t)row * NUP + pn * 256 + 128 + jl) = w;
                        }
                        if (cdst) { *(f32x4*)(cdst + j) = ua; *(f32x4*)(cdst + DFF + j) = uv; }
                    }
                }
                if (sample) continue;
                f32x4 ca[4];
                {
                    const f32x4 w0 = *(const f32x4*)(wcv + j), w1 = *(const f32x4*)(wcv + NUP + j), w2 = *(const f32x4*)(wcv + 2 * NUP + j), bb = *(const f32x4*)(bcv + j);
                    f32x4 q1 = {0.f, 0.f, 0.f, 0.f}, q2 = {0.f, 0.f, 0.f, 0.f};
#pragma unroll
                    for (int m = 0; m < 4; ++m) {
                        const f32x4 uu = acc[ai][0][m][n] * rs[m];
                        f32x4 r1, r2;
#pragma unroll
                        for (int e = 0; e < 4; ++e) { r1[e] = dppf<0x121>(uu[e]); r2[e] = dppf<0x122>(uu[e]); }
                        const f32x4 p1 = (fr >= 1) ? r1 : q1, p2 = (fr >= 2) ? r2 : q2;
                        ca[m] = bb + w0 * p2 + w1 * p1 + w2 * uu;
                        q1 = r1; q2 = r2;
                    }
                }
                {
                    const f32x4 w0 = *(const f32x4*)(wcv + DFF + j), w1 = *(const f32x4*)(wcv + NUP + DFF + j), w2 = *(const f32x4*)(wcv + 2 * NUP + DFF + j), bb = *(const f32x4*)(bcv + DFF + j);
                    f32x4 q1 = {0.f, 0.f, 0.f, 0.f}, q2 = {0.f, 0.f, 0.f, 0.f};
#pragma unroll
                    for (int m = 0; m < 4; ++m) {
                        const f32x4 uu = acc[ai][1][m][n] * rs[m];
                        f32x4 r1, r2;
#pragma unroll
                        for (int e = 0; e < 4; ++e) { r1[e] = dppf<0x121>(uu[e]); r2[e] = dppf<0x122>(uu[e]); }
                        const f32x4 p1 = (fr >= 1) ? r1 : q1, p2 = (fr >= 2) ? r2 : q2;
                        const f32x4 cv = bb + w0 * p2 + w1 * p1 + w2 * uu;
                        q1 = r1; q2 = r2;
                        if (!(m == 0 && fr < 2)) {
                            u32x2 w; w.x = pk_bf16(siluf(ca[m][0]) * cv[0], siluf(ca[m][1]) * cv[1]); w.y = pk_bf16(siluf(ca[m][2]) * cv[2], siluf(ca[m][3]) * cv[3]);
                            *(u32x2*)(act + (size_t)(rowb + 16 * m) * DFF + j) = w;
                        }
                    }
                }
            }
        }
    }
};
struct EpiDown {
    const float* h; float* out;
    __device__ __forceinline__ void operator()(const f32x4 (&acc)[2][2][4][2], const Unit& u, int wr, int wc, int fr, int fq) const {
#pragma unroll
        for (int ai = 0; ai < 2; ++ai)
#pragma unroll
            for (int m = 0; m < 4; ++m) {
                const int row = u.pm * 256 + ai * 128 + wr * 64 + m * 16 + fr;
                if (row >= NTOK) continue;
                float* yr = row < NTP ? out + O_YP + (size_t)row * DM : out + O_YS + (size_t)(row - NTP) * DM;
#pragma unroll
                for (int bj = 0; bj < 2; ++bj)
#pragma unroll
                    for (int n = 0; n < 2; ++n) {
                        const int col = u.pn * 256 + bj * 128 + wc * 32 + n * 16 + 4 * fq;
                        if (row >= NTP) {
#pragma unroll
                            for (int e = 0; e < 4; ++e) atomicAdd(yr + col + e, acc[ai][bj][m][n][e]);
                        } else *(f32x4*)(yr + col) = acc[ai][bj][m][n] + *(const f32x4*)(h + (size_t)row * DM + col);
                    }
            }
    }
};

__device__ __forceinline__ int win_srccol(int n) { return n < 3072 ? n : (n < 6144 ? n + 16 : (n < 6160 ? n - 6144 + 3072 : -1)); }

struct WtTile { const float* src; const float* g; bf16_t* dst; int ldn, K, k0, n0, srcoff, win; };
__device__ __forceinline__ WtTile wt_decode(const Params& p, int t) {
    constexpr int T_IN = 32 * 50, T_OUT = 32 * 16, T_UP = 32 * 88;
    unsigned char* ws = p.ws; WtTile w;
    if (t < T_IN) { const int kt = t & 31, nt = t >> 5; w = WtTile{p.in[7], p.in[6], (bf16_t*)(ws + W_WIN), 6160, DM, kt * 64, nt * 128, 0, 1}; }
    else if (t < T_IN + T_OUT) { const int u = t - T_IN, kt = u & 31, nt = u >> 5; w = WtTile{p.in[11], nullptr, (bf16_t*)(ws + W_WOUT), DM, DM, kt * 64, nt * 128, 0, 0}; }
    else if (t < T_IN + T_OUT + T_UP) { const int u = t - T_IN - T_OUT, kt = u & 31, nt = u >> 5;
        w = WtTile{p.in[13], p.in[12], (bf16_t*)(ws + W_WUP), NUP, DM, kt * 64, nt * 128, (nt & 1) * DFF + (nt >> 1) * 128 - nt * 128, 0}; }
    else { const int u = t - T_IN - T_OUT - T_UP, kt = u % 88, nt = u / 88; w = WtTile{p.in[16], nullptr, (bf16_t*)(ws + W_WDOWN), DM, DFF, kt * 64, nt * 128, 0, 0}; }
    return w;
}
__device__ __forceinline__ void wt_load(const WtTile& w, f32x4 (&v)[4]) {
    const int tid = threadIdx.x;
#pragma unroll
    for (int q = 0; q < 4; ++q) {
        const int idx = tid + q * 512, kk = idx >> 5, c4 = (idx & 31) * 4;
        int sc = w.n0 + c4 + w.srcoff; if (w.win) sc = win_srccol(sc);
        v[q] = (f32x4){0.f, 0.f, 0.f, 0.f};
        if (sc >= 0) v[q] = *(const f32x4*)(w.src + (size_t)(w.k0 + kk) * w.ldn + sc);
        const float gs = w.g ? w.g[w.k0 + kk] : 1.f;
        v[q] = v[q] * gs;
    }
}
__device__ __forceinline__ void wt_store(const WtTile& w, const f32x4 (&v)[4], float* T) {
    const int tid = threadIdx.x;
#pragma unroll
    for (int q = 0; q < 4; ++q) {
        const int idx = tid + q * 512, kk = idx >> 5, c4 = (idx & 31) * 4;
        T[kk * 129 + c4 + 0] = v[q][0]; T[kk * 129 + c4 + 1] = v[q][1]; T[kk * 129 + c4 + 2] = v[q][2]; T[kk * 129 + c4 + 3] = v[q][3];
    }
    __syncthreads();
#pragma unroll
    for (int q = 0; q < 2; ++q) {
        const int idx = tid + q * 512, n = idx >> 3, ch = idx & 7;
        u32x4 o;
        o.x = pk_bf16(T[(ch * 8 + 0) * 129 + n], T[(ch * 8 + 1) * 129 + n]);
        o.y = pk_bf16(T[(ch * 8 + 2) * 129 + n], T[(ch * 8 + 3) * 129 + n]);
        o.z = pk_bf16(T[(ch * 8 + 4) * 129 + n], T[(ch * 8 + 5) * 129 + n]);
        o.w = pk_bf16(T[(ch * 8 + 6) * 129 + n], T[(ch * 8 + 7) * 129 + n]);
        *(u32x4*)((unsigned char*)w.dst + ((size_t)(w.n0 >> 7) * (w.K >> 6) + (w.k0 >> 6)) * 16384 + pg8::lds_byte(n, ch * 8)) = o;
    }
    __syncthreads();
}

__device__ __forceinline__ void phase_prep(const Params& p, unsigned char* smem) {
    float* T = (float*)smem;
    const int bid = blockIdx.x, nb = gridDim.x, tid = threadIdx.x;
    unsigned char* ws = p.ws;
    {
        constexpr int NT = 32 * 50 + 32 * 16 + 32 * 88 + 88 * 16;
        f32x4 va[4], vb[4];
        int t = bid;
        if (t < NT) wt_load(wt_decode(p, t), va);
        while (t < NT) {
            const int tn = t + nb;
            if (tn < NT) wt_load(wt_decode(p, tn), vb);
            wt_store(wt_decode(p, t), va, T);
#pragma unroll
            for (int q = 0; q < 4; ++q) va[q] = vb[q];
            t = tn;
        }
    }
    {
        const int wave = tid >> 6, lane = tid & 63;
        bf16_t* xb = (bf16_t*)(ws + W_XB); float* rstd1 = (float*)(ws + W_RSTD1);
        for (int row = bid * 8 + wave; row < MPAD; row += nb * 8) {
            if (row < NTOK) {
                const float* xr = row < NTP ? p.in[0] + (size_t)row * DM : p.in[1] + (size_t)(row - NTP) * DM;
                float s = 0.f;
#pragma unroll
                for (int q = 0; q < 8; ++q) {
                    const f32x4 v = *(const f32x4*)(xr + (q * 64 + lane) * 4);
                    s += v[0] * v[0] + v[1] * v[1] + v[2] * v[2] + v[3] * v[3];
                    u32x2 w; w.x = pk_bf16(v[0], v[1]); w.y = pk_bf16(v[2], v[3]);
                    *(u32x2*)(xb + (size_t)row * DM + (q * 64 + lane) * 4) = w;
                }
#pragma unroll
                for (int o = 32; o >= 1; o >>= 1) s += __shfl_xor(s, o);
                if (lane == 0) rstd1[row] = rsqrtf(s * (1.0f / DM) + EPS);
            } else {
#pragma unroll
                for (int q = 0; q < 8; ++q) *(u32x2*)(xb + (size_t)row * DM + (q * 64 + lane) * 4) = (u32x2){0u, 0u};
                if (lane == 0) rstd1[row] = 0.f;
            }
        }
    }
    {
        float* ss2 = (float*)(ws + W_SS2); float* ss3 = (float*)(ws + W_SS3);
        for (int i = bid * NTHR + tid; i < MPAD; i += nb * NTHR) { ss2[i] = 0.f; ss3[i] = 0.f; }
        if (bid == 0 && tid < 64) ((unsigned*)(ws + W_CTL))[tid] = 0u;
        if (bid == 1 && tid < 128) ((unsigned*)(ws + W_CNT))[tid] = 0u;
    }
}

__device__ __forceinline__ void gla_prep_item(const Params& p, unsigned char* smem, int item) {
    const int tid = threadIdx.x, wave = tid >> 6, lane = tid & 63, l15 = lane & 15, quad = lane >> 4;
    const int n = item & 63, h = (item >> 6) & 3, b = item >> 8;
    const bf16_t* proj = (const bf16_t*)(p.ws + W_PROJ);
    const float* zab = (const float*)(p.ws + W_ZA);
    float* oraw = (float*)(p.ws + W_OARAW);
    bf16_t* QD = (bf16_t*)(p.ws + W_QD); bf16_t* KT = (bf16_t*)(p.ws + W_KT); bf16_t* VT = (bf16_t*)(p.ws + W_VT); float* ET = (float*)(p.ws + W_ET);
    bf16_t* qd = (bf16_t*)(smem);
    bf16_t* kd = (bf16_t*)(smem + 17408);
    unsigned char* vimg = smem + 34816;
    bf16_t* attn = (bf16_t*)(smem + 69632);
    float* zas = (float*)(smem + 78848);
    float* gsum = (float*)(smem + 82944);
    const int c = tid & 127, tg = tid >> 7;
    float wg[16];
#pragma unroll
    for (int r = 0; r < 16; ++r) wg[r] = p.in[8][r * 512 + h * 128 + c];
    const float bg = p.in[9][h * 128 + c];
    const float qscale = 0.08838834764831845f;
    const size_t tok0 = (size_t)b * SEQ + n * 64;
    if (tid < 256) *(f32x4*)(zas + tid * 4) = *(const f32x4*)(zab + tok0 * 16 + tid * 4);
#pragma unroll
    for (int q = 0; q < 4; ++q) {
        const int idx = tid + q * 512, t = idx >> 5, ch = idx & 31;
        *(u32x4*)(vimg + t * 544 + ch * 16) = *(const u32x4*)(proj + (tok0 + t) * NIN + C_VA + h * 256 + ch * 8);
    }
    float qv[16], kv[16];
#pragma unroll
    for (int i = 0; i < 16; ++i) {
        const bf16_t* pr = proj + (tok0 + tg * 16 + i) * NIN + h * 128 + c;
        qv[i] = bf2f(pr[C_QA]) * qscale; kv[i] = bf2f(pr[C_KA]);
    }
    __syncthreads();
    float cl[16]; float run = 0.f;
#pragma unroll
    for (int i = 0; i < 16; ++i) {
        const int t = tg * 16 + i; float z = bg;
#pragma unroll
        for (int r4 = 0; r4 < 4; ++r4) { const f32x4 zz = *(const f32x4*)(zas + t * 16 + r4 * 4); z += zz[0] * wg[r4 * 4] + zz[1] * wg[r4 * 4 + 1] + zz[2] * wg[r4 * 4 + 2] + zz[3] * wg[r4 * 4 + 3]; }
        run += logsigmoidf(z) * (1.0f / 16.0f); cl[i] = run;
    }
    gsum[tg * 128 + c] = run;
    __syncthreads();
    float off = 0.f, total = 0.f;
#pragma unroll
    for (int g = 0; g < 4; ++g) { const float v = gsum[g * 128 + c]; total += v; if (g < tg) off += v; }
    if (tid < 128) ET[(size_t)item * 128 + c] = __expf(total);
    unsigned ktw[8];
#pragma unroll
    for (int i = 0; i < 16; i += 2) {
        const float cum0 = off + cl[i], cum1 = off + cl[i + 1];
        const bf16_t q0 = f2bf(qv[i] * __expf(cum0)), q1 = f2bf(qv[i + 1] * __expf(cum1));
        const int t = tg * 16 + i;
        qd[t * 136 + c] = q0; qd[(t + 1) * 136 + c] = q1;
        QD[(tok0 + t) * 512 + h * 128 + c] = q0; QD[(tok0 + t + 1) * 512 + h * 128 + c] = q1;
        kd[t * 136 + c] = f2bf(kv[i] * __expf(-cum0)); kd[(t + 1) * 136 + c] = f2bf(kv[i + 1] * __expf(-cum1));
        ktw[i >> 1] = pk_bf16(kv[i] * __expf(total - cum0), kv[i + 1] * __expf(total - cum1));
    }
    {
        bf16_t* kt = KT + ((size_t)item * 128 + c) * 64 + tg * 16;
        *(u32x4*)(kt) = (u32x4){ktw[0], ktw[1], ktw[2], ktw[3]};
        *(u32x4*)(kt + 8) = (u32x4){ktw[4], ktw[5], ktw[6], ktw[7]};
    }
    __syncthreads();
    const int tt = wave >> 1;
#pragma unroll
    for (int e = 0; e < 2; ++e) {
        const int ss = (wave & 1) * 2 + e;
        f32x4 a = {0.f, 0.f, 0.f, 0.f};
        if (ss <= tt) {
#pragma unroll
            for (int ks = 0; ks < 4; ++ks) {
                const bf16x8 A = *(const bf16x8*)(qd + (16 * tt + l15) * 136 + 32 * ks + 8 * quad);
                const bf16x8 B = *(const bf16x8*)(kd + (16 * ss + l15) * 136 + 32 * ks + 8 * quad);
                a = __builtin_amdgcn_mfma_f32_16x16x32_bf16(A, B, a, 0, 0, 0);
            }
        }
#pragma unroll
        for (int j = 0; j < 4; ++j) {
            const int tr = 16 * tt + quad * 4 + j, sc = 16 * ss + l15;
            attn[tr * 72 + sc] = f2bf(sc <= tr ? a[j] : 0.f);
        }
    }
    {
        const unsigned vb = (unsigned)(size_t)vimg;
#pragma unroll
        for (int e = 0; e < 4; ++e) {
            const int pid = (wave * 4 + e) * 4 + quad, sp = pid & 7, db = pid >> 3;
            const unsigned a0 = vb + (unsigned)((8 * sp + (l15 >> 2)) * 544 + (16 * db + 4 * (l15 & 3)) * 2);
            s16x4 lo, hi;
            asm volatile("ds_read_b64_tr_b16 %0, %2\n\tds_read_b64_tr_b16 %1, %2 offset:2176\n\ts_waitcnt lgkmcnt(0)" : "=&v"(lo), "=&v"(hi) : "v"(a0) : "memory");
            *(bf16x8*)(VT + ((size_t)item * 256 + 16 * db + l15) * 64 + 8 * sp) = __builtin_shufflevector(lo, hi, 0, 1, 2, 3, 4, 5, 6, 7);
        }
    }
    __syncthreads();
    {
        const unsigned vb = (unsigned)(size_t)vimg + (unsigned)((8 * quad + (l15 >> 2)) * 544 + ((wave & 1) * 128 + 4 * (l15 & 3)) * 2);
        f32x4 o[8];
#pragma unroll
        for (int e = 0; e < 8; ++e) o[e] = (f32x4){0.f, 0.f, 0.f, 0.f};
#pragma unroll
        for (int ks = 0; ks < 2; ++ks) {
            const bf16x8 A = *(const bf16x8*)(attn + (16 * tt + l15) * 72 + 32 * ks + 8 * quad);
            s16x4 lo[8], hi[8];
            const unsigned va = vb + ks * 32 * 544;
            asm volatile(
                "ds_read_b64_tr_b16 %0, %16 offset:0\n\tds_read_b64_tr_b16 %1, %16 offset:32\n\tds_read_b64_tr_b16 %2, %16 offset:64\n\tds_read_b64_tr_b16 %3, %16 offset:96\n\t"
                "ds_read_b64_tr_b16 %4, %16 offset:128\n\tds_read_b64_tr_b16 %5, %16 offset:160\n\tds_read_b64_tr_b16 %6, %16 offset:192\n\tds_read_b64_tr_b16 %7, %16 offset:224\n\t"
                "ds_read_b64_tr_b16 %8, %16 offset:2176\n\tds_read_b64_tr_b16 %9, %16 offset:2208\n\tds_read_b64_tr_b16 %10, %16 offset:2240\n\tds_read_b64_tr_b16 %11, %16 offset:2272\n\t"
                "ds_read_b64_tr_b16 %12, %16 offset:2304\n\tds_read_b64_tr_b16 %13, %16 offset:2336\n\tds_read_b64_tr_b16 %14, %16 offset:2368\n\tds_read_b64_tr_b16 %15, %16 offset:2400\n\t"
                "s_waitcnt lgkmcnt(0)"
                : "=&v"(lo[0]), "=&v"(lo[1]), "=&v"(lo[2]), "=&v"(lo[3]), "=&v"(lo[4]), "=&v"(lo[5]), "=&v"(lo[6]), "=&v"(lo[7]),
                  "=&v"(hi[0]), "=&v"(hi[1]), "=&v"(hi[2]), "=&v"(hi[3]), "=&v"(hi[4]), "=&v"(hi[5]), "=&v"(hi[6]), "=&v"(hi[7])
                : "v"(va) : "memory");
#pragma unroll
            for (int e = 0; e < 8; ++e) {
                const bf16x8 B = __builtin_shufflevector(lo[e], hi[e], 0, 1, 2, 3, 4, 5, 6, 7);
                o[e] = __builtin_amdgcn_mfma_f32_16x16x32_bf16(B, A, o[e], 0, 0, 0);
            }
        }
#pragma unroll
        for (int e = 0; e < 8; ++e) *(f32x4*)(oraw + (tok0 + 16 * tt + l15) * 1024 + h * 256 + ((wave & 1) * 8 + e) * 16 + quad * 4) = o[e];
    }
    asm volatile("s_waitcnt vmcnt(0)" ::: "memory");
    __syncthreads();
}

constexpr int GS_KT = 0, GS_QD = 18432, GS_ET = 18432 + 17408, GS_BUF = 36352;
__device__ __forceinline__ void gla_seq_item(const Params& p, unsigned char* smem, int item) {
    const int tid = threadIdx.x, wave = tid >> 6, lane = tid & 63, l15 = lane & 15, quad = lane >> 4;
    const int half = item & 1, h = (item >> 1) & 3, b = item >> 3;
    const int dv0 = (half * 8 + wave) * 16;
    const bf16_t* QD = (const bf16_t*)(p.ws + W_QD); const bf16_t* KT = (const bf16_t*)(p.ws + W_KT); const bf16_t* VT = (const bf16_t*)(p.ws + W_VT);
    const float* ET = (const float*)(p.ws + W_ET); float* OI = (float*)(p.ws + W_OI);
    auto wait_group = [&](int g8) {
        if (tid == 0) {
            unsigned* cnt = (unsigned*)(p.ws + W_CNT) + (b * 4 + h) * 8 + g8;
            unsigned sp = 0;
            while (__hip_atomic_load(cnt, __ATOMIC_RELAXED, __HIP_MEMORY_SCOPE_AGENT) < 8u && ++sp < (1u << 20)) __builtin_amdgcn_s_sleep(8);
            __builtin_amdgcn_fence(__ATOMIC_ACQUIRE, "agent");
            asm volatile("s_waitcnt vmcnt(0)" ::: "memory");
        }
        __syncthreads();
    };
    wait_group(0);
    f32x4 S[8];
#pragma unroll
    for (int ct = 0; ct < 8; ++ct) S[ct] = (f32x4){0.f, 0.f, 0.f, 0.f};
    struct GSet { u32x4 k[2], q[2]; float e; bf16x8 v[2]; };
    const size_t ci0 = (size_t)(b * 4 + h) * 64, tokb = (size_t)b * SEQ;
    auto issue = [&](int n, GSet& s) {
        const size_t ci = ci0 + n, tok0 = tokb + (size_t)n * 64;
#pragma unroll
        for (int q = 0; q < 2; ++q) {
            const int idx = tid + q * 512;
            s.k[q] = *(const u32x4*)(KT + (ci * 128 + (idx >> 3)) * 64 + (idx & 7) * 8);
            s.q[q] = *(const u32x4*)(QD + (tok0 + (idx >> 4)) * 512 + h * 128 + (idx & 15) * 8);
        }
        s.e = 0.f; if (tid < 128) s.e = ET[ci * 128 + tid];
#pragma unroll
        for (int ks = 0; ks < 2; ++ks) s.v[ks] = *(const bf16x8*)(VT + (ci * 256 + dv0 + l15) * 64 + 32 * ks + 8 * quad);
    };
    auto stash = [&](int buf, const GSet& s) {
        unsigned char* B = smem + buf * GS_BUF;
#pragma unroll
        for (int q = 0; q < 2; ++q) {
            const int idx = tid + q * 512;
            *(u32x4*)(B + GS_KT + (idx >> 3) * 144 + (idx & 7) * 16) = s.k[q];
            *(u32x4*)(B + GS_QD + (idx >> 4) * 272 + (idx & 15) * 16) = s.q[q];
        }
        if (tid < 128) ((float*)(B + GS_ET))[tid] = s.e;
    };
    bf16x8 vt[2];
    auto step = [&](int n, GSet& sa, GSet& sb) {
        const size_t tok0 = tokb + (size_t)n * 64;
        if (n + 2 < 64 && ((n + 2) & 7) == 0) wait_group((n + 2) >> 3);
        if (n + 2 < 64) issue(n + 2, sb);
        const unsigned char* B = smem + (n & 1) * GS_BUF;
        bf16x8 Sp[4];
#pragma unroll
        for (int ks = 0; ks < 4; ++ks) {
            u32x4 w; w.x = pk_bf16(S[2 * ks][0], S[2 * ks][1]); w.y = pk_bf16(S[2 * ks][2], S[2 * ks][3]);
            w.z = pk_bf16(S[2 * ks + 1][0], S[2 * ks + 1][1]); w.w = pk_bf16(S[2 * ks + 1][2], S[2 * ks + 1][3]);
            Sp[ks] = __builtin_bit_cast(bf16x8, w);
        }
#pragma unroll
        for (int tt = 0; tt < 4; ++tt) {
            f32x4 o = {0.f, 0.f, 0.f, 0.f};
            const unsigned char* qr = B + GS_QD + (16 * tt + l15) * 272 + 8 * quad;
#pragma unroll
            for (int ks = 0; ks < 4; ++ks) {
                const u32x2 lo = *(const u32x2*)(qr + 64 * ks), hi = *(const u32x2*)(qr + 64 * ks + 32);
                const u32x4 w = {lo.x, lo.y, hi.x, hi.y};
                o = __builtin_amdgcn_mfma_f32_16x16x32_bf16(Sp[ks], __builtin_bit_cast(bf16x8, w), o, 0, 0, 0);
            }
            *(f32x4*)(OI + (tok0 + 16 * tt + l15) * 1024 + h * 256 + dv0 + 4 * quad) = o;
        }
#pragma unroll
        for (int ct = 0; ct < 8; ++ct) {
            const f32x4 et = *(const f32x4*)(B + GS_ET + (16 * ct + 4 * quad) * 4);
            S[ct] = S[ct] * et;
#pragma unroll
            for (int ks = 0; ks < 2; ++ks) {
                const bf16x8 A = *(const bf16x8*)(B + GS_KT + (16 * ct + l15) * 144 + (32 * ks + 8 * quad) * 2);
                S[ct] = __builtin_amdgcn_mfma_f32_16x16x32_bf16(A, vt[ks], S[ct], 0, 0, 0);
            }
        }
        if (n + 1 < 64) { stash((n + 1) & 1, sa); vt[0] = sa.v[0]; vt[1] = sa.v[1]; }
        __syncthreads();
    };
    GSet g0, g1;
    issue(0, g0); stash(0, g0); vt[0] = g0.v[0]; vt[1] = g0.v[1];
    __syncthreads();
    issue(1, g0);
    for (int n = 0; n < 64; n += 2) { step(n, g0, g1); step(n + 1, g1, g0); }
    float* sg = p.out + O_SGP + ((size_t)(b * 4 + h) * 128) * 256 + dv0 + l15;
#pragma unroll
    for (int ct = 0; ct < 8; ++ct)
#pragma unroll
        for (int j = 0; j < 4; ++j) sg[(size_t)(16 * ct + 4 * quad + j) * 256] = S[ct][j];
}

__device__ __forceinline__ void gla_sample_item(const Params& p, unsigned char* smem, int item) {
    const int tid = threadIdx.x;
    const int h = item & 3, s = item >> 2;
    const bf16_t* proj = (const bf16_t*)(p.ws + W_PROJ);
    const float* zab = (const float*)(p.ws + W_ZA);
    float* oraw = (float*)(p.ws + W_OARAW);
    float* la = (float*)smem;
    float* qs = la + 512;
    float* ks_ = qs + 512;
    float* vs_ = ks_ + 512;
    float* red = vs_ + 1024;
    const size_t row0 = (size_t)NTP + s * 4;
    {
        const int c = tid & 127, i = tid >> 7;
        float z = p.in[9][h * 128 + c];
#pragma unroll
        for (int r = 0; r < 16; ++r) z += zab[(row0 + i) * 16 + r] * p.in[8][r * 512 + h * 128 + c];
        la[i * 128 + c] = __expf(logsigmoidf(z) * (1.0f / 16.0f));
        const bf16_t* pr = proj + (row0 + i) * NIN + h * 128 + c;
        qs[i * 128 + c] = bf2f(pr[C_QA]) * 0.08838834764831845f;
        ks_[i * 128 + c] = bf2f(pr[C_KA]);
        for (int e = tid; e < 1024; e += NTHR) { const int ii = e >> 8, dv = e & 255; vs_[e] = bf2f(proj[(row0 + ii) * NIN + C_VA + h * 256 + dv]); }
    }
    __syncthreads();
    const int dv = tid & 255, ch = tid >> 8;
    const float* s0 = p.in[2] + ((size_t)(s * 4 + h) * 128 + ch * 64) * 256 + dv;
    float S[64];
#pragma unroll
    for (int cc = 0; cc < 64; ++cc) S[cc] = s0[(size_t)cc * 256];
#pragma unroll
    for (int i = 0; i < 4; ++i) {
        const float v = vs_[i * 256 + dv]; float o = 0.f;
#pragma unroll
        for (int c4 = 0; c4 < 64; c4 += 4) {
            const int c = ch * 64 + c4;
            const f32x4 a4 = *(const f32x4*)(la + i * 128 + c), k4 = *(const f32x4*)(ks_ + i * 128 + c), q4 = *(const f32x4*)(qs + i * 128 + c);
#pragma unroll
            for (int e = 0; e < 4; ++e) { S[c4 + e] = a4[e] * S[c4 + e] + k4[e] * v; o += q4[e] * S[c4 + e]; }
        }
        red[(i * 2 + ch) * 256 + dv] = o;
    }
    float* so = p.out + O_SGS + ((size_t)(s * 4 + h) * 128 + ch * 64) * 256 + dv;
#pragma unroll
    for (int cc = 0; cc < 64; ++cc) so[(size_t)cc * 256] = S[cc];
    __syncthreads();
    for (int e = tid; e < 1024; e += NTHR) { const int i = e >> 8, d = e & 255; oraw[(row0 + i) * 1024 + h * 256 + d] = red[(i * 2) * 256 + d] + red[(i * 2 + 1) * 256 + d]; }
    __syncthreads();
}

__device__ __forceinline__ void swa_sample_item(const Params& p, unsigned char* smem, int item) {
    const int tid = threadIdx.x, wave = tid >> 6, lane = tid & 63, sub = lane & 15, grp = lane >> 4;
    const int h = item & 7, s = item >> 3;
    const int i = wave & 3, hf = wave >> 2;
    const int kk0 = hf * 196, kk1 = hf ? 387 : 196;
    const bf16_t* proj = (const bf16_t*)(p.ws + W_PROJ);
    float* sc = (float*)smem + wave * 200;
    float* mrg = (float*)smem + 1600;
    const size_t rowq = (size_t)NTP + s * 4 + i;
    float q[8];
    { const u32x4 w = *(const u32x4*)(proj + rowq * NIN + C_QB + h * 128 + sub * 8);
      q[0] = bflo(w.x); q[1] = bfhi(w.x); q[2] = bflo(w.y); q[3] = bfhi(w.y); q[4] = bflo(w.z); q[5] = bfhi(w.z); q[6] = bflo(w.w); q[7] = bfhi(w.w); }
    const float slope = exp2f(-(float)(h + 1));
    const float* ck = p.in[3] + (size_t)s * 2048 * 1024 + h * 128;
    const float* cv = p.in[4] + (size_t)s * 2048 * 1024 + h * 128;
    const bf16_t* nk = proj + ((size_t)NTP + s * 4) * NIN + C_KB + h * 128;
    const bf16_t* nv = proj + ((size_t)NTP + s * 4) * NIN + C_VB + h * 128;
    for (int it0 = 0; it0 < 52; it0 += 13) {
        float kvv[13][8]; float bias[13];
#pragma unroll
        for (int u = 0; u < 13; ++u) {
            int kk = kk0 + (it0 + u) * 4 + grp; if (kk >= kk1) kk = kk1 - 1;
            const int g = kk / 129, j = kk - g * 129, dil = 1 << (2 * g);
            const int idx = 2048 + i - dil * j;
            bias[u] = slope * (float)(dil * j);
            if (idx < 2048) {
                const f32x4 a = *(const f32x4*)(ck + (size_t)idx * 1024 + sub * 8), b2 = *(const f32x4*)(ck + (size_t)idx * 1024 + sub * 8 + 4);
                kvv[u][0] = a[0]; kvv[u][1] = a[1]; kvv[u][2] = a[2]; kvv[u][3] = a[3]; kvv[u][4] = b2[0]; kvv[u][5] = b2[1]; kvv[u][6] = b2[2]; kvv[u][7] = b2[3];
            } else {
                const u32x4 w = *(const u32x4*)(nk + (size_t)(idx - 2048) * NIN + sub * 8);
                kvv[u][0] = bflo(w.x); kvv[u][1] = bfhi(w.x); kvv[u][2] = bflo(w.y); kvv[u][3] = bfhi(w.y); kvv[u][4] = bflo(w.z); kvv[u][5] = bfhi(w.z); kvv[u][6] = bflo(w.w); kvv[u][7] = bfhi(w.w);
            }
        }
#pragma unroll
        for (int u = 0; u < 13; ++u) {
            float d = 0.f;
#pragma unroll
            for (int e = 0; e < 8; ++e) d += q[e] * kvv[u][e];
            d += __shfl_xor(d, 1); d += __shfl_xor(d, 2); d += __shfl_xor(d, 4); d += __shfl_xor(d, 8);
            const int kl = (it0 + u) * 4 + grp;
            if (sub == 0 && kl < 196) sc[kl] = (kk0 + kl < kk1) ? d * 0.08838834764831845f - bias[u] : -1e30f;
        }
    }
    __builtin_amdgcn_s_waitcnt(0);
    __builtin_amdgcn_wave_barrier();
    float mx = -1e30f;
    for (int kl = lane; kl < 196; kl += 64) mx = fmaxf(mx, sc[kl]);
#pragma unroll
    for (int o = 32; o >= 1; o >>= 1) mx = fmaxf(mx, __shfl_xor(mx, o));
    float l = 0.f;
    for (int kl = lane; kl < 196; kl += 64) { const float sv = sc[kl]; const float e = sv > -1e29f ? __expf(sv - mx) : 0.f; sc[kl] = e; l += e; }
#pragma unroll
    for (int o = 32; o >= 1; o >>= 1) l += __shfl_xor(l, o);
    __builtin_amdgcn_s_waitcnt(0);
    __builtin_amdgcn_wave_barrier();
    float o0 = 0.f, o1 = 0.f;
    for (int kb = 0; kb < 196; kb += 28) {
        float v0[28], v1[28], pw[28];
#pragma unroll
        for (int u = 0; u < 28; ++u) {
            int kk = kk0 + kb + u; if (kk >= kk1) kk = kk1 - 1;
            const int g = kk / 129, j = kk - g * 129, dil = 1 << (2 * g);
            const int idx = 2048 + i - dil * j;
            pw[u] = sc[kb + u];
            if (idx < 2048) { const f32x2 v = *(const f32x2*)(cv + (size_t)idx * 1024 + lane * 2); v0[u] = v[0]; v1[u] = v[1]; }
            else { const unsigned w = *(const unsigned*)(nv + (size_t)(idx - 2048) * NIN + lane * 2); v0[u] = bflo(w); v1[u] = bfhi(w); }
        }
#pragma unroll
        for (int u = 0; u < 28; ++u) { o0 += pw[u] * v0[u]; o1 += pw[u] * v1[u]; }
    }
    if (hf == 1) { mrg[i * 132 + lane * 2] = o0; mrg[i * 132 + lane * 2 + 1] = o1; if (lane == 0) { mrg[i * 132 + 128] = mx; mrg[i * 132 + 129] = l; } }
    __syncthreads();
    if (hf == 0) {
        const float m1 = mrg[i * 132 + 128], l1 = mrg[i * 132 + 129];
        const float mm = fmaxf(mx, m1), e0 = __expf(mx - mm), e1 = __expf(m1 - mm);
        const float inv = 1.0f / (l * e0 + l1 * e1);
        const float r0 = (o0 * e0 + mrg[i * 132 + lane * 2] * e1) * inv, r1 = (o1 * e0 + mrg[i * 132 + lane * 2 + 1] * e1) * inv;
        bf16_t* mix = (bf16_t*)(p.ws + W_MIX);
        *(unsigned*)(mix + rowq * DM + 1024 + h * 128 + lane * 2) = pk_bf16(r0, r1);
    }
    __syncthreads();
}

__device__ __forceinline__ void copy_item(const Params& p, int item) {
    const int which = item >> 9, b = (item >> 4) & 31, piece = item & 15;
    constexpr int PIECE = 32704;
    const f32x4* src = (const f32x4*)(p.in[3 + which] + (size_t)b * 2048 * 1024 + 4096) + (size_t)piece * PIECE;
    f32x4* dst = (f32x4*)(p.out + (which ? O_CVS : O_CKS) + (size_t)b * 2048 * 1024) + (size_t)piece * PIECE;
    const int tid = threadIdx.x;
    for (int j0 = 0; j0 < 64; j0 += 32) {
        f32x4 v[32];
#pragma unroll
        for (int u = 0; u < 32; ++u) { const int idx = tid + (j0 + u) * 512; if (idx < PIECE) v[u] = __builtin_nontemporal_load(src + idx); }
#pragma unroll
        for (int u = 0; u < 32; ++u) { const int idx = tid + (j0 + u) * 512; if (idx < PIECE) __builtin_nontemporal_store(v[u], dst + idx); }
    }
}
constexpr int NCOPY = 1024;
__device__ __forceinline__ void copy_worker(const Params& p, unsigned char* smem, int phase_slot, int ngemm) {
    unsigned* ctl = (unsigned*)(p.ws + W_CTL);
    int* slot = (int*)(smem + LDS_BYTES - 16);
    for (;;) {
        if (threadIdx.x == 0) {
            int q = NCOPY;
            if (ngemm == 0 || (int)__hip_atomic_load(ctl + 33 + phase_slot, __ATOMIC_RELAXED, __HIP_MEMORY_SCOPE_AGENT) < ngemm) q = (int)atomicAdd(ctl + 32, 1u);
            *slot = q;
        }
        __syncthreads();
        const int q = *slot;
        __syncthreads();
        if (q >= NCOPY) break;
        copy_item(p, q);
    }
}
__device__ __forceinline__ void gemm_done(const Params& p, int phase_slot) {
    if (threadIdx.x == 0) atomicAdd((unsigned*)(p.ws + W_CTL) + 33 + phase_slot, 1u);
}

constexpr int KPITCH = 272, VPITCH = 288, KIMG = 0, VIMG = 272 * 272;
struct SwaItem { int g, b, h, dil, res, ib; };
__device__ __forceinline__ SwaItem swa_decode(int item) {
    SwaItem s; const int bh = item / 96, r96 = item - bh * 96; s.g = r96 >> 5; s.b = bh >> 3; s.h = bh & 7; const int blk = r96 & 31;
    s.dil = 1 << (2 * s.g); const int nblk = 32 >> (2 * s.g); s.res = blk / nblk; s.ib = blk % nblk; return s;
}
__device__ __forceinline__ void swa_issue(const Params& p, int item, u32x4 (&kr)[9], u32x4 (&vr)[9], bf16x8 (&Qf)[4]) {
    const int tid = threadIdx.x, wave = tid >> 6, lane = tid & 63, l15 = lane & 15, quad = lane >> 4;
    const SwaItem s = swa_decode(item);
    const bf16_t* proj = (const bf16_t*)(p.ws + W_PROJ);
    const size_t rowb = (size_t)s.b * SEQ;
    const int kp0 = 128 * (s.ib - 1) - 16;
#pragma unroll
    for (int q = 0; q < 9; ++q) {
        const int idx = tid + q * 512, lr = idx >> 4, ch = idx & 15, kp = kp0 + lr;
        kr[q] = (u32x4){0u, 0u, 0u, 0u}; vr[q] = (u32x4){0u, 0u, 0u, 0u};
        if (kp >= 0 && lr < 272) {
            const size_t off = ((size_t)(s.b * 8 + s.h) * SEQ + (size_t)kp * s.dil + s.res) * 128 + ch * 8;
            kr[q] = *(const u32x4*)((const bf16_t*)(p.ws + W_KC) + off); vr[q] = *(const u32x4*)((const bf16_t*)(p.ws + W_VC) + off);
        }
    }
    const int qp = 128 * s.ib + 16 * wave + l15;
    const size_t qrow = rowb + (size_t)qp * s.dil + s.res;
#pragma unroll
    for (int ks = 0; ks < 4; ++ks) Qf[ks] = *(const bf16x8*)(proj + qrow * NIN + C_QB + s.h * 128 + 32 * ks + 8 * quad);
}
__device__ __forceinline__ void swa_stash(unsigned char* smem, const u32x4 (&kr)[9], const u32x4 (&vr)[9]) {
    const int tid = threadIdx.x;
#pragma unroll
    for (int q = 0; q < 9; ++q) {
        const int idx = tid + q * 512, lr = idx >> 4, ch = idx & 15;
        if (lr < 272) { *(u32x4*)(smem + KIMG + lr * KPITCH + ch * 16) = kr[q]; *(u32x4*)(smem + VIMG + lr * VPITCH + ch * 16) = vr[q]; }
    }
}
__device__ __forceinline__ void swa_compute(const Params& p, unsigned char* smem, int item, const bf16x8 (&Qf)[4]) {
    const int tid = threadIdx.x, wave = tid >> 6, lane = tid & 63, l15 = lane & 15, quad = lane >> 4;
    const SwaItem s = swa_decode(item);
    const int g = s.g, h = s.h, dil = s.dil, ib = s.ib;
    const size_t rowb = (size_t)s.b * SEQ;
    const int kp0 = 128 * (ib - 1) - 16;
    const int qp = 128 * ib + 16 * wave + l15;
    const size_t qrow = rowb + (size_t)qp * dil + s.res;
    const float SC2 = 0.08838834764831845f * 1.4426950408889634f;
    const float SL2 = exp2f(-(float)(h + 1)) * (float)dil * 1.4426950408889634f;
    f32x4 O[8];
#pragma unroll
    for (int dt = 0; dt < 8; ++dt) O[dt] = (f32x4){0.f, 0.f, 0.f, 0.f};
    float mrun = -1e30f, lrun = 0.f;
    const unsigned vbase = (unsigned)(size_t)(smem + VIMG);
    for (int pr = 0; pr < 5; ++pr) {
        const int lrb = 16 * wave + 32 * pr, kpb = kp0 + lrb;
        if (kpb + 31 < 0) continue;
        f32x4 sacc[2];
#pragma unroll
        for (int T = 0; T < 2; ++T) {
            sacc[T] = (f32x4){0.f, 0.f, 0.f, 0.f};
#pragma unroll
            for (int ks = 0; ks < 4; ++ks) {
                const bf16x8 A = *(const bf16x8*)(smem + KIMG + (lrb + 16 * T + l15) * KPITCH + (32 * ks + 8 * quad) * 2);
                sacc[T] = __builtin_amdgcn_mfma_f32_16x16x32_bf16(A, Qf[ks], sacc[T], 0, 0, 0);
            }
        }
        s16x4 lo[8], hi[8];
        {
            const unsigned va = vbase + (unsigned)((lrb + quad * 4 + (l15 >> 2)) * VPITCH + (4 * (l15 & 3)) * 2);
            asm volatile(
                "ds_read_b64_tr_b16 %0, %16 offset:0\n\tds_read_b64_tr_b16 %1, %16 offset:32\n\tds_read_b64_tr_b16 %2, %16 offset:64\n\tds_read_b64_tr_b16 %3, %16 offset:96\n\t"
                "ds_read_b64_tr_b16 %4, %16 offset:128\n\tds_read_b64_tr_b16 %5, %16 offset:160\n\tds_read_b64_tr_b16 %6, %16 offset:192\n\tds_read_b64_tr_b16 %7, %16 offset:224\n\t"
                "ds_read_b64_tr_b16 %8, %16 offset:4608\n\tds_read_b64_tr_b16 %9, %16 offset:4640\n\tds_read_b64_tr_b16 %10, %16 offset:4672\n\tds_read_b64_tr_b16 %11, %16 offset:4704\n\t"
                "ds_read_b64_tr_b16 %12, %16 offset:4736\n\tds_read_b64_tr_b16 %13, %16 offset:4768\n\tds_read_b64_tr_b16 %14, %16 offset:4800\n\tds_read_b64_tr_b16 %15, %16 offset:4832\n\t"
                "s_waitcnt lgkmcnt(0)"
                : "=&v"(lo[0]), "=&v"(lo[1]), "=&v"(lo[2]), "=&v"(lo[3]), "=&v"(lo[4]), "=&v"(lo[5]), "=&v"(lo[6]), "=&v"(lo[7]),
                  "=&v"(hi[0]), "=&v"(hi[1]), "=&v"(hi[2]), "=&v"(hi[3]), "=&v"(hi[4]), "=&v"(hi[5]), "=&v"(hi[6]), "=&v"(hi[7])
                : "v"(va) : "memory");
        }
        float sv[8]; bool ok[8]; float mx = -1e30f;
#pragma unroll
        for (int T = 0; T < 2; ++T)
#pragma unroll
            for (int j = 0; j < 4; ++j) {
                const int kp = kpb + 16 * T + quad * 4 + j, dist = qp - kp;
                const bool v = (dist >= 0) && (dist <= 128) && (kp >= 0);
                const float s2 = sacc[T][j] * SC2 - SL2 * (float)dist;
                ok[T * 4 + j] = v; sv[T * 4 + j] = s2; if (v) mx = fmaxf(mx, s2);
            }
        mx = fmaxf(mx, __shfl_xor(mx, 16)); mx = fmaxf(mx, __shfl_xor(mx, 32));
        const float mnew = fmaxf(mrun, mx), alpha = exp2f(mrun - mnew);
        mrun = mnew;
        float pv[8], ps = 0.f;
#pragma unroll
        for (int e = 0; e < 8; ++e) { pv[e] = ok[e] ? exp2f(sv[e] - mnew) : 0.f; ps += pv[e]; }
        lrun = lrun * alpha + ps;
        u32x4 pw; pw.x = pk_bf16(pv[0], pv[1]); pw.y = pk_bf16(pv[2], pv[3]); pw.z = pk_bf16(pv[4], pv[5]); pw.w = pk_bf16(pv[6], pv[7]);
        const bf16x8 P = __builtin_bit_cast(bf16x8, pw);
#pragma unroll
        for (int dt = 0; dt < 8; ++dt) {
            const bf16x8 A = __builtin_shufflevector(lo[dt], hi[dt], 0, 1, 2, 3, 4, 5, 6, 7);
            O[dt] = O[dt] * alpha;
            O[dt] = __builtin_amdgcn_mfma_f32_16x16x32_bf16(A, P, O[dt], 0, 0, 0);
        }
    }
    lrun += __shfl_xor(lrun, 16); lrun += __shfl_xor(lrun, 32);
    const float inv = 1.0f / lrun;
    bf16_t* ob = (bf16_t*)(p.ws + W_OB3) + ((size_t)g * NTP + qrow) * 1024 + h * 128;
#pragma unroll
    for (int dt = 0; dt < 8; ++dt) {
        u32x2 w; w.x = pk_bf16(O[dt][0] * inv, O[dt][1] * inv); w.y = pk_bf16(O[dt][2] * inv, O[dt][3] * inv);
        *(u32x2*)(ob + 16 * dt + quad * 4) = w;
    }
    if (quad == 0) ((float*)(p.ws + W_LSE3))[((size_t)g * NTP + qrow) * 8 + h] = (mrun + log2f(lrun)) * 0.6931471805599453f;
}

__device__ __forceinline__ void phase_mix(const Params& p, unsigned char* smem) {
    const int tid = threadIdx.x;
    unsigned* qctr = (unsigned*)(p.ws + W_CTL);
    int* slot = (int*)(smem + LDS_BYTES - 16);
    int pending = -1;
    const bool seqwg = (int)blockIdx.x < 32;
    while (!seqwg) {
        if (tid == 0) {
            if (pending >= 0) {
                __builtin_amdgcn_fence(__ATOMIC_RELEASE, "agent");
                asm volatile("s_waitcnt vmcnt(0)" ::: "memory");
                __hip_atomic_fetch_add((unsigned*)(p.ws + W_CNT) + pending, 1u, __ATOMIC_RELAXED, __HIP_MEMORY_SCOPE_AGENT);
            }
            *slot = (int)atomicAdd(qctr, 1u);
        }
        __syncthreads();
        const int q = *slot;
        __syncthreads();
        if (q >= 1024) break;
        const int g8 = q >> 7, bh = (q >> 3) & 15, nn = g8 * 8 + (q & 7);
        gla_prep_item(p, smem, bh * 64 + nn);
        pending = bh * 8 + g8;
    }
    __syncthreads();
    if (seqwg) {
        gla_seq_item(p, smem, blockIdx.x);
    } else {
        for (;;) {
            if (tid == 0) *slot = (int)atomicAdd(qctr + 1, 1u);
            __syncthreads();
            const int q = *slot;
            __syncthreads();
            if (q >= 128) break;
            gla_sample_item(p, smem, q);
        }
        for (;;) {
            if (tid == 0) *slot = (int)atomicAdd(qctr + 2, 1u);
            __syncthreads();
            const int q = *slot;
            __syncthreads();
            if (q >= 256) break;
            swa_sample_item(p, smem, q);
        }
    }
    unsigned* qb = qctr + 16;
    if (tid == 0) *slot = (int)atomicAdd(qb, 1u);
    __syncthreads();
    int item = *slot;
    __syncthreads();
    u32x4 kr[9], vr[9]; bf16x8 Qf[4], Qn[4];
    if (item < 3072) swa_issue(p, item, kr, vr, Qf);
    while (item < 3072) {
        if (tid == 0) *slot = (int)atomicAdd(qb, 1u);
        swa_stash(smem, kr, vr);
        __syncthreads();
        const int next = *slot;
        if (next < 3072) swa_issue(p, next, kr, vr, Qn);
        swa_compute(p, smem, item, Qf);
        __syncthreads();
        item = next;
#pragma unroll
        for (int ks = 0; ks < 4; ++ks) Qf[ks] = Qn[ks];
    }
}

__device__ __forceinline__ void phase_combine(const Params& p) {
    const int tid = threadIdx.x, wave = tid >> 6, lane = tid & 63;
    const bf16_t* proj = (const bf16_t*)(p.ws + W_PROJ);
    const float* oraw = (const float*)(p.ws + W_OARAW);
    const bf16_t* ob3 = (const bf16_t*)(p.ws + W_OB3);
    const float* lse3 = (const float*)(p.ws + W_LSE3);
    bf16_t* mix = (bf16_t*)(p.ws + W_MIX);
    for (int row = blockIdx.x * 8 + wave; row < NTOK; row += gridDim.x * 8) {
        {
            const float* o = oraw + (size_t)row * 1024 + lane * 16;
            const float* o2 = (const float*)(p.ws + W_OI) + (size_t)row * 1024 + lane * 16;
            f32x4 v[4]; float s = 0.f;
#pragma unroll
            for (int q = 0; q < 4; ++q) { v[q] = *(const f32x4*)(o + q * 4); if (row < NTP) v[q] = v[q] + *(const f32x4*)(o2 + q * 4); s += v[q][0] * v[q][0] + v[q][1] * v[q][1] + v[q][2] * v[q][2] + v[q][3] * v[q][3]; }
            s += __shfl_xor(s, 1); s += __shfl_xor(s, 2); s += __shfl_xor(s, 4); s += __shfl_xor(s, 8);
            const float rs = rsqrtf(s * (1.0f / 256.0f) + EPS);
            const u32x4 g0 = *(const u32x4*)(proj + (size_t)row * NIN + C_GA + lane * 16), g1 = *(const u32x4*)(proj + (size_t)row * NIN + C_GA + lane * 16 + 8);
            const unsigned gw[8] = {g0.x, g0.y, g0.z, g0.w, g1.x, g1.y, g1.z, g1.w};
            unsigned ow[8];
#pragma unroll
            for (int e = 0; e < 8; ++e) {
                const float ga0 = bflo(gw[e]), ga1 = bfhi(gw[e]);
                const float x0 = v[e >> 1][(e & 1) * 2] * rs * p.in[10][lane * 16 + 2 * e] * siluf(ga0);
                const float x1 = v[e >> 1][(e & 1) * 2 + 1] * rs * p.in[10][lane * 16 + 2 * e + 1] * siluf(ga1);
                ow[e] = pk_bf16(x0, x1);
            }
            *(u32x4*)(mix + (size_t)row * DM + lane * 16) = (u32x4){ow[0], ow[1], ow[2], ow[3]};
            *(u32x4*)(mix + (size_t)row * DM + lane * 16 + 8) = (u32x4){ow[4], ow[5], ow[6], ow[7]};
        }
        if (row < NTP) {
            const int h = lane >> 3;
            const float l0 = lse3[((size_t)0 * NTP + row) * 8 + h], l1 = lse3[((size_t)1 * NTP + row) * 8 + h], l2 = lse3[((size_t)2 * NTP + row) * 8 + h];
            const float mx = fmaxf(l0, fmaxf(l1, l2));
            float w0 = __expf(l0 - mx), w1 = __expf(l1 - mx), w2 = __expf(l2 - mx);
            const float inv = 1.0f / (w0 + w1 + w2); w0 *= inv; w1 *= inv; w2 *= inv;
            unsigned ow[8];
            const u32x4* a0 = (const u32x4*)(ob3 + ((size_t)0 * NTP + row) * 1024 + lane * 16);
            const u32x4* a1 = (const u32x4*)(ob3 + ((size_t)1 * NTP + row) * 1024 + lane * 16);
            const u32x4* a2 = (const u32x4*)(ob3 + ((size_t)2 * NTP + row) * 1024 + lane * 16);
#pragma unroll
            for (int hh = 0; hh < 2; ++hh) {
                const u32x4 x0 = a0[hh], x1 = a1[hh], x2 = a2[hh];
#pragma unroll
                for (int e = 0; e < 4; ++e) {
                    const float lo = w0 * bflo(x0[e]) + w1 * bflo(x1[e]) + w2 * bflo(x2[e]);
                    const float hi = w0 * bfhi(x0[e]) + w1 * bfhi(x1[e]) + w2 * bfhi(x2[e]);
                    ow[hh * 4 + e] = pk_bf16(lo, hi);
                }
            }
            *(u32x4*)(mix + (size_t)row * DM + 1024 + lane * 16) = (u32x4){ow[0], ow[1], ow[2], ow[3]};
            *(u32x4*)(mix + (size_t)row * DM + 1024 + lane * 16 + 8) = (u32x4){ow[4], ow[5], ow[6], ow[7]};
        }
    }
}

__device__ __forceinline__ void phase_convgate(const Params& p) {
    const bf16_t* U = (const bf16_t*)(p.ws + W_U);
    bf16_t* act = (bf16_t*)(p.ws + W_ACT);
    const float* wc = p.in[14]; const float* bc = p.in[15]; const float* cs = p.in[5];
    for (int i = blockIdx.x * NTHR + threadIdx.x; i < NTS * DM / 4; i += gridDim.x * NTHR)
        ((f32x4*)(p.out + O_YS))[i] = ((const f32x4*)((const float*)(p.ws + W_H) + (size_t)NTP * DM))[i];
    constexpr int NCG = DFF / 8;
    constexpr int NROW = 512 + NTS;
    const int total = NCG * NROW;
    for (int uid = blockIdx.x * NTHR + threadIdx.x; uid < total; uid += gridDim.x * NTHR) {
        const int ridx = uid / NCG, j0 = (uid % NCG) * 8;
        const int r = ridx < 512 ? 64 * (ridx >> 1) + (ridx & 1) : NTP + (ridx - 512);
        const int uc = 256 * (j0 >> 7) + (j0 & 127);
        float ca[8], cv[8], h1a[8], h1v[8], h2a[8], h2v[8];
        auto ldrow = [&](size_t row, float* a, float* v) {
            const u32x4 x = *(const u32x4*)(U + row * NUP + uc), y = *(const u32x4*)(U + row * NUP + uc + 128);
#pragma unroll
            for (int e = 0; e < 4; ++e) { a[2 * e] = bflo(x[e]); a[2 * e + 1] = bfhi(x[e]); v[2 * e] = bflo(y[e]); v[2 * e + 1] = bfhi(y[e]); }
        };
        auto zero = [&](float* a, float* v) {
#pragma unroll
            for (int e = 0; e < 8; ++e) { a[e] = 0.f; v[e] = 0.f; } };
        auto ldstate = [&](int s, int k, float* a, float* v) {
#pragma unroll
            for (int e = 0; e < 8; ++e) { a[e] = cs[(size_t)(s * 2 + k) * NUP + j0 + e]; v[e] = cs[(size_t)(s * 2 + k) * NUP + DFF + j0 + e]; } };
        ldrow((size_t)r, ca, cv);
        if (r < NTP) {
            const int t = r & 4095;
            if (t >= 1) ldrow((size_t)r - 1, h1a, h1v); else zero(h1a, h1v);
            if (t >= 2) ldrow((size_t)r - 2, h2a, h2v); else zero(h2a, h2v);
        } else {
            const int s = (r - NTP) >> 2, i = (r - NTP) & 3;
            if (i >= 1) ldrow((size_t)r - 1, h1a, h1v); else ldstate(s, 1, h1a, h1v);
            if (i >= 2) ldrow((size_t)r - 2, h2a, h2v); else ldstate(s, i, h2a, h2v);
        }
        unsigned ow[4];
#pragma unroll
        for (int e = 0; e < 8; e += 2) {
            float o[2];
#pragma unroll
            for (int k = 0; k < 2; ++k) {
                const int jj = j0 + e + k;
                const float a = bc[jj] + wc[jj] * h2a[e + k] + wc[NUP + jj] * h1a[e + k] + wc[2 * NUP + jj] * ca[e + k];
                const float v = bc[DFF + jj] + wc[DFF + jj] * h2v[e + k] + wc[NUP + DFF + jj] * h1v[e + k] + wc[2 * NUP + DFF + jj] * cv[e + k];
                o[k] = siluf(a) * v;
            }
            ow[e >> 1] = pk_bf16(o[0], o[1]);
        }
        *(u32x4*)(act + (size_t)r * DFF + j0) = (u32x4){ow[0], ow[1], ow[2], ow[3]};
    }
}

__device__ __forceinline__ void phase_final(const Params& p) {
    const float* gf = p.in[17];
    const int tid = threadIdx.x, wave = tid >> 6, lane = tid & 63;
    for (int row = blockIdx.x * 8 + wave; row < NTOK; row += gridDim.x * 8) {
        float* yr = row < NTP ? p.out + O_YP + (size_t)row * DM : p.out + O_YS + (size_t)(row - NTP) * DM;
        f32x4 v[8]; float s = 0.f;
#pragma unroll
        for (int q = 0; q < 8; ++q) { v[q] = *(const f32x4*)(yr + (q * 64 + lane) * 4); s += v[q][0] * v[q][0] + v[q][1] * v[q][1] + v[q][2] * v[q][2] + v[q][3] * v[q][3]; }
#pragma unroll
        for (int o = 32; o >= 1; o >>= 1) s += __shfl_xor(s, o);
        const float rs = rsqrtf(s * (1.0f / DM) + EPS);
#pragma unroll
        for (int q = 0; q < 8; ++q) {
            const int c = (q * 64 + lane) * 4;
            *(f32x4*)(yr + c) = v[q] * rs * *(const f32x4*)(gf + c);
        }
    }
}

constexpr int NPHASE = 10;
constexpr int NC_IN = 16, NC_OUT = 80, NC_UP = 16;
__global__ void __launch_bounds__(512, 2) fwd_kernel(Params p) {
    extern __shared__ __attribute__((aligned(16))) unsigned char smem[];
    unsigned char* ws = p.ws;
    const int lo = p.ph_lo, hi = p.ph_hi;
    volatile LAS unsigned* xst = (volatile LAS unsigned*)(LAS unsigned char*)(smem + LDS_BYTES - 32);
    if (threadIdx.x == 0) { xst[0] = 0u; xst[1] = 0u; }
    __syncthreads();
    (void)xcd_barrier_post((unsigned*)(ws + W_BAR), xst);
#define PH_BEGIN(k) if (lo <= (k) && (k) < hi) { if ((k) > lo) { if ((k) == 1 && p.ph_hi > NPHASE) cg::this_grid().sync(); else { XcdBarrier xb_; xb_.bar = (unsigned*)(p.ws + W_BAR); xb_.x = xb_xcc_id(); xb_.st = (volatile LAS unsigned*)(LAS unsigned char*)(smem + LDS_BYTES - 32); xcd_barrier(xb_); } }
#define PH_END }
    PH_BEGIN(0) phase_prep(p, smem); PH_END
    PH_BEGIN(1) {
        pg8::StaticOrder S;
        pg8::Gemm g{(const bf16_t*)(ws + W_XB), (const bf16_t*)(ws + W_WIN), MPAD, NIN, DM};
        const int ng = (int)gridDim.x - NC_IN;
        if ((int)blockIdx.x >= ng) copy_worker(p, smem, 0, ng);
        else {
            S.init(MPAD, NIN, DM, ng, blockIdx.x);
            EpiIn E{(bf16_t*)(ws + W_PROJ), (const float*)(ws + W_RSTD1), (float*)(ws + W_ZA), p.out, (bf16_t*)(ws + W_KC), (bf16_t*)(ws + W_VC)};
            pg8::gemm_phase(((LAS unsigned char*)smem), g, S, E);
            gemm_done(p, 0);
        }
    } PH_END
    PH_BEGIN(2) phase_mix(p, smem); PH_END
    PH_BEGIN(4) phase_combine(p); PH_END
    PH_BEGIN(5) {
        pg8::StaticOrder S;
        pg8::Gemm g{(const bf16_t*)(ws + W_MIX), (const bf16_t*)(ws + W_WOUT), MPAD, DM, DM};
        const int ng = (int)gridDim.x - NC_OUT;
        if ((int)blockIdx.x >= ng) copy_worker(p, smem, 1, ng);
        else {
            S.init(MPAD, DM, DM, ng, blockIdx.x);
            EpiOut E{p.in[0], p.in[1], (float*)(ws + W_H), (bf16_t*)(ws + W_HB), (float*)(ws + W_SS2)};
            pg8::gemm_phase(((LAS unsigned char*)smem), g, S, E);
            gemm_done(p, 1);
        }
    } PH_END
    PH_BEGIN(6) {
        pg8::StaticOrder S;
        pg8::Gemm g{(const bf16_t*)(ws + W_HB), (const bf16_t*)(ws + W_WUP), MPAD, NUP, DM};
        const int ng = (int)gridDim.x - NC_UP;
        if ((int)blockIdx.x >= ng) copy_worker(p, smem, 2, ng);
        else {
            S.init(MPAD, NUP, DM, ng, blockIdx.x);
            EpiUp E{(bf16_t*)(ws + W_U), (bf16_t*)(ws + W_ACT), (const float*)(ws + W_SS2), p.out, p.in[14], p.in[15]};
            pg8::gemm_phase(((LAS unsigned char*)smem), g, S, E);
            gemm_done(p, 2);
        }
    } PH_END
    PH_BEGIN(7) phase_convgate(p); PH_END
    PH_BEGIN(8) {
        pg8::StaticOrder S;
        pg8::Gemm g{(const bf16_t*)(ws + W_ACT), (const bf16_t*)(ws + W_WDOWN), MPAD, DM, DFF};
        S.init(MPAD, DM, DFF, gridDim.x, blockIdx.x, 22);
        EpiDown E{(const float*)(ws + W_H), p.out};
        pg8::gemm_phase<EpiDown, true>(((LAS unsigned char*)smem), g, S, E);
    } PH_END
    PH_BEGIN(9) copy_worker(p, smem, 0, 0); phase_final(p); PH_END
}

extern "C" void kernel_launch(void* const* d_in, const int* in_sizes, int n_in, void* d_out, int out_size, void* d_ws, size_t ws_size, hipStream_t stream) {
    static int grid = 0;
    if (grid == 0) {
        if (n_in != 18 || (size_t)out_size != O_END || ws_size < W_END) { fprintf(stderr, "kernel_launch: unexpected sizes n_in %d out %d ws %zu (need %zu)\n", n_in, out_size, ws_size, (size_t)W_END); grid = -1; return; }
        int dev = 0, cus = 0, per_cu = 0;
        hipGetDevice(&dev);
        hipDeviceGetAttribute(&cus, hipDeviceAttributeMultiprocessorCount, dev);
        if (hipFuncSetAttribute((const void*)fwd_kernel, hipFuncAttributeMaxDynamicSharedMemorySize, LDS_BYTES) != hipSuccess) { fprintf(stderr, "kernel_launch: hipFuncSetAttribute failed\n"); grid = -1; return; }
        if (hipOccupancyMaxActiveBlocksPerMultiprocessor(&per_cu, (const void*)fwd_kernel, NTHR, LDS_BYTES) != hipSuccess || per_cu < 1) { fprintf(stderr, "kernel_launch: occupancy query gave %d\n", per_cu); per_cu = 1; }
        (void)hipGetLastError();
        grid = cus * 1;
        if (grid <= 0) grid = 256;
    }
    if (grid < 0) return;
    Params p{};
    for (int i = 0; i < 18; ++i) p.in[i] = (const float*)d_in[i];
    p.out = (float*)d_out; p.ws = (unsigned char*)d_ws;
#if ONE_LAUNCH
    if (hipMemsetAsync((char*)d_ws + W_BAR, 0, 16384, stream) != hipSuccess) { fprintf(stderr, "kernel_launch: memset of the barrier words failed\n"); return; }
    p.ph_lo = 0; p.ph_hi = NPHASE;
    void* args[] = {&p};
    hipError_t e = hipLaunchCooperativeKernel((const void*)fwd_kernel, dim3(grid), dim3(NTHR), args, LDS_BYTES, stream);
    if (e != hipSuccess) fprintf(stderr, "cooperative launch failed: %s (grid %d)\n", hipGetErrorString(e), grid);
#else
    for (int ph = 0; ph < NPHASE; ++ph) {
        p.ph_lo = ph; p.ph_hi = ph + 1;
        hipLaunchKernelGGL(fwd_kernel, dim3(grid), dim3(NTHR), LDS_BYTES, stream, p);
    }
#endif
}
```

```cpp
#include <hip/hip_runtime.h>
#include <hip/hip_cooperative_groups.h>
#include <cstdio>
#include <cstdint>
namespace cg = cooperative_groups;

#ifndef ONE_LAUNCH
#define ONE_LAUNCH 1
#endif

#define LAS __attribute__((address_space(3)))
typedef unsigned short bf16_t;
typedef short bf16x8 __attribute__((ext_vector_type(8)));
typedef short s16x4 __attribute__((ext_vector_type(4)));
typedef float f32x4 __attribute__((ext_vector_type(4)));
typedef float f32x2 __attribute__((ext_vector_type(2)));
typedef unsigned u32x4 __attribute__((ext_vector_type(4)));
typedef unsigned u32x2 __attribute__((ext_vector_type(2)));
typedef __bf16 bf16v2 __attribute__((ext_vector_type(2)));

constexpr int DM = 2048;
constexpr int NTP = 16384, NTS = 128, NTOK = NTP + NTS, MPAD = 16640;
constexpr int SEQ = 4096;
constexpr int NIN = 6400;
constexpr int C_QA = 0, C_KA = 512, C_VA = 1024, C_GA = 2048, C_QB = 3072, C_KB = 4096, C_VB = 5120, C_ZA = 6144;
constexpr int DFF = 5632, NUP = 11264;
constexpr float EPS = 1e-6f;
constexpr int NTHR = 512;
constexpr int LDS_BYTES = 152320;

constexpr size_t O_YP = 0;
constexpr size_t O_YS = O_YP + (size_t)NTP * DM;
constexpr size_t O_SGP = O_YS + (size_t)NTS * DM;
constexpr size_t O_SGS = O_SGP + (size_t)4 * 4 * 128 * 256;
constexpr size_t O_CKP = O_SGS + (size_t)32 * 4 * 128 * 256;
constexpr size_t O_CKS = O_CKP + (size_t)4 * 2048 * 1024;
constexpr size_t O_CVP = O_CKS + (size_t)32 * 2048 * 1024;
constexpr size_t O_CVS = O_CVP + (size_t)4 * 2048 * 1024;
constexpr size_t O_CONVP = O_CVS + (size_t)32 * 2048 * 1024;
constexpr size_t O_CONVS = O_CONVP + (size_t)4 * 2 * NUP;
constexpr size_t O_END = O_CONVS + (size_t)32 * 2 * NUP;

constexpr size_t al256(size_t x) { return (x + 255) & ~(size_t)255; }
constexpr size_t W_WIN = 0;
constexpr size_t W_WOUT = W_WIN + al256((size_t)NIN * DM * 2);
constexpr size_t W_WUP = W_WOUT + al256((size_t)DM * DM * 2);
constexpr size_t W_WDOWN = W_WUP + al256((size_t)NUP * DM * 2);
constexpr size_t W_RSTD1 = W_WDOWN + al256((size_t)DM * DFF * 2);
constexpr size_t W_SS2 = W_RSTD1 + al256((size_t)MPAD * 4);
constexpr size_t W_SS3 = W_SS2 + al256((size_t)MPAD * 4);
constexpr size_t W_CTL = W_SS3 + al256((size_t)MPAD * 4);
constexpr size_t W_CNT = W_CTL + 256;
constexpr size_t W_BAR = W_CNT + 512;
constexpr size_t W_H = W_BAR + 16384;
constexpr size_t W_HB = W_H + al256((size_t)MPAD * DM * 4);
constexpr size_t W_RA = W_HB + al256((size_t)MPAD * DM * 2);
constexpr size_t W_XB = W_RA;
constexpr size_t W_ZA = W_XB + al256((size_t)MPAD * DM * 2);
constexpr size_t W_PROJ = W_ZA + al256((size_t)MPAD * 16 * 4);
constexpr size_t W_OARAW = W_PROJ + al256((size_t)MPAD * NIN * 2);
constexpr size_t W_OB3 = W_OARAW + al256((size_t)MPAD * 1024 * 4);
constexpr size_t W_LSE3 = W_OB3 + al256((size_t)3 * NTP * 1024 * 2);
constexpr size_t W_MIX = W_LSE3 + al256((size_t)3 * NTP * 8 * 4);
constexpr size_t W_QD = W_MIX + al256((size_t)MPAD * DM * 2);
constexpr size_t W_KT = W_QD + al256((size_t)NTP * 512 * 2);
constexpr size_t W_VT = W_KT + al256((size_t)1024 * 128 * 64 * 2);
constexpr size_t W_ET = W_VT + al256((size_t)1024 * 256 * 64 * 2);
constexpr size_t W_OI = W_ET + al256((size_t)1024 * 128 * 4);
constexpr size_t W_KC = W_OI + al256((size_t)NTP * 1024 * 4);
constexpr size_t W_VC = W_KC + al256((size_t)NTP * 1024 * 2);
constexpr size_t W_RA_END = W_VC + al256((size_t)NTP * 1024 * 2);
constexpr size_t W_U = W_RA;
constexpr size_t W_U_END = W_U + al256((size_t)MPAD * NUP * 2);
constexpr size_t W_ACT = W_U_END;
constexpr size_t W_ACT_END = W_ACT + al256((size_t)MPAD * DFF * 2);
constexpr size_t W_END = (W_RA_END > W_ACT_END ? W_RA_END : W_ACT_END);
static_assert(W_END <= ((size_t)1 << 30), "workspace too large");

struct Params {
    const float* in[18];
    float* out;
    unsigned char* ws;
    int ph_lo, ph_hi;
};

__device__ __forceinline__ unsigned pk_bf16(float a, float b) { f32x2 v = {a, b}; bf16v2 r = __builtin_convertvector(v, bf16v2); return __builtin_bit_cast(unsigned, r); }
__device__ __forceinline__ float bf2f(unsigned short b) { return __uint_as_float(((unsigned)b) << 16); }
__device__ __forceinline__ float bflo(unsigned w) { return __uint_as_float(w << 16); }
__device__ __forceinline__ float bfhi(unsigned w) { return __uint_as_float(w & 0xffff0000u); }
__device__ __forceinline__ bf16_t f2bf(float a) { return (bf16_t)(pk_bf16(a, 0.f) & 0xffffu); }
__device__ __forceinline__ s16x4 tr_read(unsigned lds_addr) { s16x4 r; asm volatile("ds_read_b64_tr_b16 %0, %1\n\ts_waitcnt lgkmcnt(0)" : "=&v"(r) : "v"(lds_addr) : "memory"); return r; }
__device__ __forceinline__ float siluf(float x) { return x * __builtin_amdgcn_rcpf(1.f + __expf(-x)); }
__device__ __forceinline__ float logsigmoidf(float z) { return fminf(z, 0.f) - __logf(1.0f + __expf(-fabsf(z))); }

namespace pg8 { __host__ __device__ __forceinline__ int lds_byte(int r, int c); }
#define XB_TMO      128
#define XB_XCNT(j)  (256  + 64 * (j))
#define XB_XSUB(j)  (1280 + 64 * (j))
#define XB_XGEN(j)  (2304 + 64 * (j))
#define XB_TOP      3328
#define XB_TOPGEN   3392
#define XCD_BAR_WORDS 3456
#define XB_SPIN_CAP (1u << 20)
__device__ __forceinline__ unsigned xb_ld(unsigned* p)              { return __hip_atomic_load(p, __ATOMIC_RELAXED, __HIP_MEMORY_SCOPE_AGENT); }
__device__ __forceinline__ unsigned xb_add(unsigned* p, unsigned v) { return __hip_atomic_fetch_add(p, v, __ATOMIC_RELAXED, __HIP_MEMORY_SCOPE_AGENT); }
__device__ __forceinline__ unsigned xb_xcc_id() { return (unsigned)__builtin_amdgcn_s_getreg((3 << 11) | 20) & 0xFu; }
#define XB_SPIN(cond, bar) do { unsigned _sp = 0; while (cond) { __builtin_amdgcn_s_sleep(1); \
    if ((++_sp & 255u) == 0u) { if (xb_ld(&(bar)[XB_TMO])) break; if (_sp > XB_SPIN_CAP) { atomicAdd(&(bar)[XB_TMO], 1u); break; } } } } while (0)
struct XcdBarrier { unsigned* bar; unsigned x; volatile LAS unsigned* st; };
__device__ __forceinline__ XcdBarrier xcd_barrier_post(unsigned* bar, volatile LAS unsigned* st) {
    XcdBarrier b; b.bar = bar; b.x = xb_xcc_id(); b.st = st;
    if (threadIdx.x == 0) (void)xb_add(&bar[XB_XCNT(b.x)], 1u);
    return b;
}
__device__ __forceinline__ void xcd_barrier_complete(unsigned* bar, unsigned x, unsigned& nloc, unsigned& nx) {
    const unsigned G = gridDim.x * gridDim.y * gridDim.z;
    unsigned sum, cnt, mine, sp = 0u;
    for (;;) {
        sum = 0u; cnt = 0u; mine = 0u;
#pragma unroll
        for (unsigned j = 0; j < 16; ++j) { const unsigned c = xb_ld(&bar[XB_XCNT(j)]); sum += c; cnt += (c > 0u) ? 1u : 0u; mine = (j == x) ? c : mine; }
        if (sum == G) break;
        __builtin_amdgcn_s_sleep(1);
        if ((++sp & 255u) == 0u) { if (xb_ld(&bar[XB_TMO])) break; if (sp > XB_SPIN_CAP) { atomicAdd(&bar[XB_TMO], 1u); break; } }
    }
    nloc = mine > 0u ? mine : 1u; nx = cnt > 0u ? cnt : 1u;
}
__device__ __forceinline__ void xcd_barrier(const XcdBarrier& b) {
    asm volatile("s_waitcnt vmcnt(0)" ::: "memory");
    __syncthreads();
    if (threadIdx.x == 0) {
        unsigned* bar = b.bar;
        __builtin_amdgcn_s_waitcnt(0);
        unsigned nloc = b.st[0], nx = b.st[1];
        if (nloc == 0u) { xcd_barrier_complete(bar, b.x, nloc, nx); b.st[0] = nloc; b.st[1] = nx; }
        const unsigned old = xb_add(&bar[XB_XSUB(b.x)], 1u);
        const unsigned gen = old / nloc;
        if (old + 1u == (gen + 1u) * nloc) {
            __builtin_amdgcn_fence(__ATOMIC_RELEASE, "agent");
            asm volatile("s_waitcnt vmcnt(0)" ::: "memory");
            const unsigned og = xb_add(&bar[XB_TOP], 1u);
            const unsigned tg = og / nx;
            if (og + 1u == (tg + 1u) * nx) xb_add(&bar[XB_TOPGEN], 1u);
            else XB_SPIN(xb_ld(&bar[XB_TOPGEN]) == tg, bar);
            __builtin_amdgcn_fence(__ATOMIC_ACQUIRE, "agent");
            xb_add(&bar[XB_XGEN(b.x)], 1u);
            asm volatile("s_waitcnt vmcnt(0)" ::: "memory");
        } else {
            XB_SPIN(xb_ld(&bar[XB_XGEN(b.x)]) == gen, bar);
            __builtin_amdgcn_fence(__ATOMIC_ACQUIRE, "agent");
            asm volatile("s_waitcnt vmcnt(0)" ::: "memory");
        }
    }
    __syncthreads();
}

namespace pg8 {
constexpr int BM = 256, BK = 64, HALF = 128, HTB = HALF * BK * 2, STAGE_BYTES = 8 * HTB, NXCD = 8, WGM = 8;
__host__ __device__ __forceinline__ int lds_byte(int r, int c) { const int st = (r >> 4) * 2 + (c >> 5), rr = r & 15, cc = c & 31, ob = rr * 64 + cc * 2; return st * 1024 + (ob ^ (((ob >> 9) & 1) << 5)); }
__host__ __device__ __forceinline__ void stage_rc(int b, int& R, int& C) { const int st = b / 1024, sb = b % 1024, swz = sb ^ (((sb >> 9) & 1) << 5); R = (st >> 1) * 16 + swz / 64; C = (st & 1) * 32 + (swz % 64) / 2; }
struct Unit { int pm, pn; };
struct Gemm { const bf16_t* A; const bf16_t* Bt; int M, N, K; };
struct StaticOrder {
    int nM, nN, nwg, G, c, ntK, tsplit;
    __host__ __device__ void init(int M, int N, int K, int G_, int c_, int tsplit_ = 1) { nM = M / BM - 1; nN = N / BM; nwg = nM * nN; G = G_; c = c_; ntK = K / BK; tsplit = tsplit_; }
    __host__ __device__ bool next(int i, Unit& u) const {
        const long L = (long)i * G + c; if (L >= nwg + nN * tsplit) return false;
        if (L >= nwg) { const int idx = (int)(L - nwg); u.pm = nM; u.pn = (idx % nN) | ((idx / nN) << 8); return true; }
        int wgid = (int)L; { const int q = nwg / NXCD, r = nwg % NXCD, xcd = wgid % NXCD, off = wgid / NXCD; wgid = (xcd < r ? xcd * (q + 1) : r * (q + 1) + (xcd - r) * q) + off; }
        const int nig = WGM * nN, gid = wgid / nig, fm = gid * WGM, gsz = (nM - fm) < WGM ? (nM - fm) : WGM;
        u.pm = fm + ((wgid % nig) % gsz); u.pn = (wgid % nig) / gsz; return true;
    }
};

template <class Epi, bool KSPLIT = false>
__device__ __forceinline__ void gemm_phase(LAS unsigned char* lds, const Gemm g, const StaticOrder& S, const Epi& E) {
    const int tid = threadIdx.x, wid = __builtin_amdgcn_readfirstlane(tid >> 6), lane = tid & 63, wr = wid >> 2, wc = wid & 3, fr = lane & 15, fq = lane >> 4;
    const int K = g.K;
    unsigned voffA[2], voffB[2];
#pragma unroll
    for (int i = 0; i < 2; ++i) { int R, C; stage_rc(tid * 16 + i * 8192, R, C); voffA[i] = (unsigned)(R * K + C) * 2u; voffB[i] = (unsigned)(tid * 16 + i * 8192); }
    const size_t kstep = (size_t)(BK * 2);
    const size_t hstep = (size_t)HALF * K * 2;
    const size_t tstep = 2 * hstep;
    const size_t kstepB = 16384, hstepB = (size_t)(K / BK) * 16384, tstepB = 2 * hstepB;
    const unsigned ldsw = (unsigned)wid * 1024u;
    const int aoff = lds_byte(wr * 64 + fr, fq * 8), boff = lds_byte(wc * 32 + fr, fq * 8);
#define PG8_SA(b, h) (((b) * 2 + (h)) * HTB)
#define PG8_SB(b, h) ((4 + (b) * 2 + (h)) * HTB)
#define PG8_STAGE(bufoff, gbase, voff) do { _Pragma("unroll") for (int _i = 0; _i < 2; ++_i) \
        __builtin_amdgcn_global_load_lds((const unsigned*)((const char*)(gbase) + (voff)[_i]), (LAS unsigned*)(lds + (bufoff) + ldsw + _i * 8192), 16, 0, 0); } while (0)
#define PG8_LDA(dst, b, h) do { _Pragma("unroll") for (int m = 0; m < 4; ++m) _Pragma("unroll") for (int k = 0; k < 2; ++k) dst[m][k] = *(const LAS bf16x8*)(lds + PG8_SA(b, h) + aoff + m * 2048 + k * 1024); } while (0)
#define PG8_LDB(dst, b, h) do { _Pragma("unroll") for (int n = 0; n < 2; ++n) _Pragma("unroll") for (int k = 0; k < 2; ++k) dst[n][k] = *(const LAS bf16x8*)(lds + PG8_SB(b, h) + boff + n * 2048 + k * 1024); } while (0)
#define PG8_MMA(ai, bj, At, Bt) do { __builtin_amdgcn_s_setprio(1); _Pragma("unroll") for (int m = 0; m < 4; ++m) _Pragma("unroll") for (int n = 0; n < 2; ++n) _Pragma("unroll") for (int k = 0; k < 2; ++k) \
        acc[ai][bj][m][n] = __builtin_amdgcn_mfma_f32_16x16x32_bf16(Bt[n][k], At[m][k], acc[ai][bj][m][n], 0, 0, 0); __builtin_amdgcn_s_setprio(0); } while (0)
#define PG8_WAIT_V(n) asm volatile("s_waitcnt vmcnt(" #n ")" ::: "memory")
#define PG8_WAIT_L(n) asm volatile("s_waitcnt lgkmcnt(" #n ")" ::: "memory")
#define PG8_BAR __builtin_amdgcn_s_barrier()
#define PG8_SCHED __builtin_amdgcn_sched_barrier(0)
    Unit cur, nxt; int ui = 0;
    if (!S.next(0, cur)) return;
    f32x4 acc[2][2][4][2];
#pragma unroll
    for (int a = 0; a < 2; ++a)
#pragma unroll
        for (int b = 0; b < 2; ++b)
#pragma unroll
            for (int m = 0; m < 4; ++m)
#pragma unroll
                for (int n = 0; n < 2; ++n) acc[a][b][m][n] = (f32x4){0.f, 0.f, 0.f, 0.f};
    bf16x8 At[4][2], B0[2][2], B1[2][2];
    const int ntail = S.ntK / S.tsplit;
    const char* cA = (const char*)g.A + (size_t)cur.pm * tstep + (KSPLIT ? (size_t)((cur.pn >> 8) * ntail) * kstep : 0); const char* cB = (const char*)g.Bt + (size_t)(cur.pn & 255) * tstepB + (KSPLIT ? (size_t)((cur.pn >> 8) * ntail) * kstepB : 0);
    PG8_STAGE(PG8_SB(0, 0), cB, voffB); PG8_STAGE(PG8_SA(0, 0), cA, voffA); PG8_STAGE(PG8_SB(0, 1), cB + hstepB, voffB); PG8_STAGE(PG8_SA(0, 1), cA + hstep, voffA);
    if (wr == 1) PG8_BAR;
    PG8_WAIT_V(4); PG8_BAR;
    PG8_STAGE(PG8_SB(1, 0), cB + kstepB, voffB); PG8_STAGE(PG8_SA(1, 0), cA + kstep, voffA); PG8_STAGE(PG8_SB(1, 1), cB + hstepB + kstepB, voffB);
    PG8_WAIT_V(6); PG8_BAR;
    for (;;) {
        const bool has_next = S.next(ui + 1, nxt);
        const char* nA = has_next ? (const char*)g.A + (size_t)nxt.pm * tstep + (KSPLIT ? (size_t)((nxt.pn >> 8) * ntail) * kstep : 0) : cA; const char* nB = has_next ? (const char*)g.Bt + (size_t)(nxt.pn & 255) * tstepB + (KSPLIT ? (size_t)((nxt.pn >> 8) * ntail) * kstepB : 0) : cB;
        const int nt = (KSPLIT && cur.pm == S.nM) ? ntail : K / BK;
        for (int t = 0; t < nt; t += 2) {
            const bool last = (t == nt - 2);
            const char* a1 = cA + (size_t)(t + 1) * kstep;
            const char* a2 = last ? nA : cA + (size_t)(t + 2) * kstep; const char* b2 = last ? nB : cB + (size_t)(t + 2) * kstepB;
            const char* a3 = a2 + kstep; const char* b3 = b2 + kstepB;
            PG8_LDB(B0, 0, 0); PG8_SCHED; PG8_LDA(At, 0, 0); PG8_STAGE(PG8_SA(1, 1), a1 + hstep, voffA);
            PG8_WAIT_L(8); PG8_BAR; PG8_WAIT_L(0); PG8_MMA(0, 0, At, B0); PG8_BAR; PG8_SCHED;
            PG8_LDB(B1, 0, 1); PG8_STAGE(PG8_SB(0, 0), b2, voffB);
            PG8_BAR; PG8_WAIT_L(0); PG8_MMA(0, 1, At, B1); PG8_BAR;
            PG8_LDA(At, 0, 1); PG8_STAGE(PG8_SA(0, 0), a2, voffA);
            PG8_BAR; PG8_WAIT_L(0); PG8_MMA(1, 0, At, B0); PG8_BAR; PG8_SCHED;
            PG8_STAGE(PG8_SB(0, 1), b2 + hstepB, voffB);
            PG8_WAIT_V(6); PG8_BAR; PG8_MMA(1, 1, At, B1); PG8_BAR;
            PG8_LDB(B0, 1, 0); PG8_SCHED; PG8_LDA(At, 1, 0); PG8_STAGE(PG8_SA(0, 1), a2 + hstep, voffA);
            PG8_WAIT_L(8); PG8_BAR; PG8_WAIT_L(0); PG8_MMA(0, 0, At, B0); PG8_BAR; PG8_SCHED;
            PG8_LDB(B1, 1, 1); PG8_STAGE(PG8_SB(1, 0), b3, voffB);
            PG8_BAR; PG8_WAIT_L(0); PG8_MMA(0, 1, At, B1); PG8_BAR;
            PG8_LDA(At, 1, 1); PG8_STAGE(PG8_SA(1, 0), a3, voffA);
            PG8_BAR; PG8_WAIT_L(0); PG8_MMA(1, 0, At, B0); PG8_BAR; PG8_SCHED;
            PG8_STAGE(PG8_SB(1, 1), b3 + hstepB, voffB);
            PG8_WAIT_V(6); PG8_BAR; PG8_MMA(1, 1, At, B1); PG8_BAR;
        }
        { Unit ue; ue.pm = cur.pm; ue.pn = cur.pn & 255; E(acc, ue, wr, wc, fr, fq); }
        if (!has_next) break;
#pragma unroll
        for (int a = 0; a < 2; ++a)
#pragma unroll
            for (int b = 0; b < 2; ++b)
#pragma unroll
                for (int m = 0; m < 4; ++m)
#pragma unroll
                    for (int n = 0; n < 2; ++n) acc[a][b][m][n] = (f32x4){0.f, 0.f, 0.f, 0.f};
        cur = nxt; cA = nA; cB = nB; ++ui;
    }
    PG8_WAIT_V(0);
    if (wr == 0) PG8_BAR;
    PG8_BAR;
#undef PG8_SA
#undef PG8_SB
#undef PG8_STAGE
#undef PG8_LDA
#undef PG8_LDB
#undef PG8_MMA
#undef PG8_WAIT_V
#undef PG8_WAIT_L
#undef PG8_BAR
#undef PG8_SCHED
}
}
using pg8::Unit;

struct EpiIn {
    bf16_t* proj; const float* rstd1; float* za; float* out; bf16_t* kc; bf16_t* vc;
    __device__ __forceinline__ void operator()(const f32x4 (&acc)[2][2][4][2], const Unit& u, int wr, int wc, int fr, int fq) const {
        const int pn = u.pn;
#pragma unroll
        for (int ai = 0; ai < 2; ++ai)
#pragma unroll
            for (int m = 0; m < 4; ++m) {
                const int row = u.pm * 256 + ai * 128 + wr * 64 + m * 16 + fr;
                if (row >= NTOK) continue;
                const float rs = rstd1[row];
                float* kvdst = nullptr;
                if (pn >= 16 && pn < 24) {
                    if (row < NTP) { const int b = row >> 12, t = row & 4095; if (t >= 2048) kvdst = out + (pn >= 20 ? O_CVP : O_CKP) + ((size_t)(b * 2048 + t - 2048)) * 1024; }
                    else { const int s = (row - NTP) >> 2, i = (row - NTP) & 3; kvdst = out + (pn >= 20 ? O_CVS : O_CKS) + ((size_t)(s * 2048 + 2044 + i)) * 1024; }
                }
#pragma unroll
                for (int bj = 0; bj < 2; ++bj)
#pragma unroll
                    for (int n = 0; n < 2; ++n) {
                        const int col = pn * 256 + bj * 128 + wc * 32 + n * 16 + 4 * fq;
                        const f32x4 v = acc[ai][bj][m][n] * rs;
                        u32x2 w; w.x = pk_bf16(v[0], v[1]); w.y = pk_bf16(v[2], v[3]);
                        *(u32x2*)(proj + (size_t)row * NIN + col) = w;
                        if (kvdst) *(f32x4*)(kvdst + (col - (pn >= 20 ? C_VB : C_KB))) = v;
                        if (pn >= 16 && pn < 24 && row < NTP) { const int cc = col - (pn >= 20 ? C_VB : C_KB); *(u32x2*)((pn >= 20 ? vc : kc) + ((size_t)((row >> 12) * 8 + (cc >> 7)) * SEQ + (row & 4095)) * 128 + (cc & 127)) = w; }
                        if (pn == 24 && col < C_ZA + 16) *(f32x4*)(za + (size_t)row * 16 + (col - C_ZA)) = v;
                    }
            }
    }
};
struct EpiOut {
    const float* xp; const float* xs; float* h; bf16_t* hb; float* ss;
    __device__ __forceinline__ void operator()(const f32x4 (&acc)[2][2][4][2], const Unit& u, int wr, int wc, int fr, int fq) const {
#pragma unroll
        for (int ai = 0; ai < 2; ++ai)
#pragma unroll
            for (int m = 0; m < 4; ++m) {
                const int row = u.pm * 256 + ai * 128 + wr * 64 + m * 16 + fr;
                if (row >= NTOK) continue;
                const float* xr = row < NTP ? xp + (size_t)row * DM : xs + (size_t)(row - NTP) * DM;
                float s = 0.f;
#pragma unroll
                for (int bj = 0; bj < 2; ++bj)
#pragma unroll
                    for (int n = 0; n < 2; ++n) {
                        const int col = u.pn * 256 + bj * 128 + wc * 32 + n * 16 + 4 * fq;
                        const f32x4 v = acc[ai][bj][m][n] + *(const f32x4*)(xr + col);
                        *(f32x4*)(h + (size_t)row * DM + col) = v;
                        u32x2 w; w.x = pk_bf16(v[0], v[1]); w.y = pk_bf16(v[2], v[3]);
                        *(u32x2*)(hb + (size_t)row * DM + col) = w;
                        s += v[0] * v[0] + v[1] * v[1] + v[2] * v[2] + v[3] * v[3];
                    }
                s += __shfl_xor(s, 16); s += __shfl_xor(s, 32);
                if (fq == 0) atomicAdd(ss + row, s);
            }
    }
};
template <int CTRL> __device__ __forceinline__ float dppf(float x) { return __builtin_bit_cast(float, __builtin_amdgcn_update_dpp(0, __builtin_bit_cast(int, x), CTRL, 0xf, 0xf, false)); }
struct EpiUp {
    bf16_t* U; bf16_t* act; const float* ss; float* out; const float* wcv; const float* bcv;
    __device__ __forceinline__ void operator()(const f32x4 (&acc)[2][2][4][2], const Unit& u, int wr, int wc, int fr, int fq) const {
        const int pn = u.pn;
#pragma unroll
        for (int ai = 0; ai < 2; ++ai) {
            const int rowb = u.pm * 256 + ai * 128 + wr * 64 + fr;
            if (rowb - fr >= NTOK) continue;
            float rs[4];
#pragma unroll
            for (int m = 0; m < 4; ++m) rs[m] = rsqrtf(ss[rowb + 16 * m] * (1.0f / DM) + EPS);
            const bool sample = rowb >= NTP;
#pragma unroll
            for (int n = 0; n < 2; ++n) {
                const int jl = wc * 32 + n * 16 + 4 * fq, j = pn * 128 + jl;
#pragma unroll
                for (int m = 0; m < 4; ++m) {
                    const int row = rowb + 16 * m;
                    const bool raw = sample || (m == 0 && fr < 2) || (m == 3 && fr >= 14);
                    float* cdst = nullptr;
                    if (!sample) { const int b = row >> 12, t = row & 4095; if (t >= 4094) cdst = out + O_CONVP + (size_t)(b * 2 + (t - 4094)) * NUP; }
                    else { const int s = (row - NTP) >> 2, i = (row - NTP) & 3; if (i >= 2) cdst = out + O_CONVS + (size_t)(s * 2 + (i - 2)) * NUP; }
                    if (raw || cdst) {
                        const f32x4 ua = acc[ai][0][m][n] * rs[m], uv = acc[ai][1][m][n] * rs[m];
                        if (raw) {
                            u32x2 w; w.x = pk_bf16(ua[0], ua[1]); w.y = pk_bf16(ua[2], ua[3]);
                            *(u32x2*)(U + (size_t)row * NUP + pn * 256 + jl) = w;
                            w.x = pk_bf16(uv[0], uv[1]); w.y = pk_bf16(uv[2], uv[3]);
                            *(u32x2*)(U + (size_t)row * NUP + pn * 256 + 128 + jl) = w;
                        }
                        if (cdst) { *(f32x4*)(cdst + j) = ua; *(f32x4*)(cdst + DFF + j) = uv; }
                    }
                }
                if (sample) continue;
                f32x4 ca[4];
                {
                    const f32x4 w0 = *(const f32x4*)(wcv + j), w1 = *(const f32x4*)(wcv + NUP + j), w2 = *(const f32x4*)(wcv + 2 * NUP + j), bb = *(const f32x4*)(bcv + j);
                    f32x4 q1 = {0.f, 0.f, 0.f, 0.f}, q2 = {0.f, 0.f, 0.f, 0.f};
#pragma unroll
                    for (int m = 0; m < 4; ++m) {
                        const f32x4 uu = acc[ai][0][m][n] * rs[m];
                        f32x4 r1, r2;
#pragma unroll
                        for (int e = 0; e < 4; ++e) { r1[e] = dppf<0x121>(uu[e]); r2[e] = dppf<0x122>(uu[e]); }
                        const f32x4 p1 = (fr >= 1) ? r1 : q1, p2 = (fr >= 2) ? r2 : q2;
                        ca[m] = bb + w0 * p2 + w1 * p1 + w2 * uu;
                        q1 = r1; q2 = r2;
                    }
                }
                {
                    const f32x4 w0 = *(const f32x4*)(wcv + DFF + j), w1 = *(const f32x4*)(wcv + NUP + DFF + j), w2 = *(const f32x4*)(wcv + 2 * NUP + DFF + j), bb = *(const f32x4*)(bcv + DFF + j);
                    f32x4 q1 = {0.f, 0.f, 0.f, 0.f}, q2 = {0.f, 0.f, 0.f, 0.f};
#pragma unroll
                    for (int m = 0; m < 4; ++m) {
                        const f32x4 uu = acc[ai][1][m][n] * rs[m];
                        f32x4 r1, r2;
#pragma unroll
                        for (int e = 0; e < 4; ++e) { r1[e] = dppf<0x121>(uu[e]); r2[e] = dppf<0x122>(uu[e]); }
                        const f32x4 p1 = (fr >= 1) ? r1 : q1, p2 = (fr >= 2) ? r2 : q2;
                        const f32x4 cv = bb + w0 * p2 + w1 * p1 + w2 * uu;
                        q1 = r1; q2 = r2;
                        if (!(m == 0 && fr < 2)) {
                            u32x2 w; w.x = pk_bf16(siluf(ca[m][0]) * cv[0], siluf(ca[m][1]) * cv[1]); w.y = pk_bf16(siluf(ca[m][2]) * cv[2], siluf(ca[m][3]) * cv[3]);
                            *(u32x2*)(act + (size_t)(rowb + 16 * m) * DFF + j) = w;
                        }
                    }
                }
            }
        }
    }
};
struct EpiDown {
    const float* h; float* out;
    __device__ __forceinline__ void operator()(const f32x4 (&acc)[2][2][4][2], const Unit& u, int wr, int wc, int fr, int fq) const {
#pragma unroll
        for (int ai = 0; ai < 2; ++ai)
#pragma unroll
            for (int m = 0; m < 4; ++m) {
                const int row = u.pm * 256 + ai * 128 + wr * 64 + m * 16 + fr;
                if (row >= NTOK) continue;
                float* yr = row < NTP ? out + O_YP + (size_t)row * DM : out + O_YS + (size_t)(row - NTP) * DM;
#pragma unroll
                for (int bj = 0; bj < 2; ++bj)
#pragma unroll
                    for (int n = 0; n < 2; ++n) {
                        const int col = u.pn * 256 + bj * 128 + wc * 32 + n * 16 + 4 * fq;
                        if (row >= NTP) {
#pragma unroll
                            for (int e = 0; e < 4; ++e) atomicAdd(yr + col + e, acc[ai][bj][m][n][e]);
                        } else *(f32x4*)(yr + col) = acc[ai][bj][m][n] + *(const f32x4*)(h + (size_t)row * DM + col);
                    }
            }
    }
};

__device__ __forceinline__ int win_srccol(int n) { return n < 3072 ? n : (n < 6144 ? n + 16 : (n < 6160 ? n - 6144 + 3072 : -1)); }

struct WtTile { const float* src; const float* g; bf16_t* dst; int ldn, K, k0, n0, srcoff, win; };
__device__ __forceinline__ WtTile wt_decode(const Params& p, int t) {
    constexpr int T_IN = 32 * 50, T_OUT = 32 * 16, T_UP = 32 * 88;
    unsigned char* ws = p.ws; WtTile w;
    if (t < T_IN) { const int kt = t & 31, nt = t >> 5; w = WtTile{p.in[7], p.in[6], (bf16_t*)(ws + W_WIN), 6160, DM, kt * 64, nt * 128, 0, 1}; }
    else if (t < T_IN + T_OUT) { const int u = t - T_IN, kt = u & 31, nt = u >> 5; w = WtTile{p.in[11], nullptr, (bf16_t*)(ws + W_WOUT), DM, DM, kt * 64, nt * 128, 0, 0}; }
    else if (t < T_IN + T_OUT + T_UP) { const int u = t - T_IN - T_OUT, kt = u & 31, nt = u >> 5;
        w = WtTile{p.in[13], p.in[12], (bf16_t*)(ws + W_WUP), NUP, DM, kt * 64, nt * 128, (nt & 1) * DFF + (nt >> 1) * 128 - nt * 128, 0}; }
    else { const int u = t - T_IN - T_OUT - T_UP, kt = u % 88, nt = u / 88; w = WtTile{p.in[16], nullptr, (bf16_t*)(ws + W_WDOWN), DM, DFF, kt * 64, nt * 128, 0, 0}; }
    return w;
}
__device__ __forceinline__ void wt_load(const WtTile& w, f32x4 (&v)[4]) {
    const int tid = threadIdx.x;
#pragma unroll
    for (int q = 0; q < 4; ++q) {
        const int idx = tid + q * 512, kk = idx >> 5, c4 = (idx & 31) * 4;
        int sc = w.n0 + c4 + w.srcoff; if (w.win) sc = win_srccol(sc);
        v[q] = (f32x4){0.f, 0.f, 0.f, 0.f};
        if (sc >= 0) v[q] = *(const f32x4*)(w.src + (size_t)(w.k0 + kk) * w.ldn + sc);
        const float gs = w.g ? w.g[w.k0 + kk] : 1.f;
        v[q] = v[q] * gs;
    }
}
__device__ __forceinline__ void wt_store(const WtTile& w, const f32x4 (&v)[4], float* T) {
    const int tid = threadIdx.x;
#pragma unroll
    for (int q = 0; q < 4; ++q) {
        const int idx = tid + q * 512, kk = idx >> 5, c4 = (idx & 31) * 4;
        T[kk * 129 + c4 + 0] = v[q][0]; T[kk * 129 + c4 + 1] = v[q][1]; T[kk * 129 + c4 + 2] = v[q][2]; T[kk * 129 + c4 + 3] = v[q][3];
    }
    __syncthreads();
#pragma unroll
    for (int q = 0; q < 2; ++q) {
        const int idx = tid + q * 512, n = idx >> 3, ch = idx & 7;
        u32x4 o;
        o.x = pk_bf16(T[(ch * 8 + 0) * 129 + n], T[(ch * 8 + 1) * 129 + n]);
        o.y = pk_bf16(T[(ch * 8 + 2) * 129 + n], T[(ch * 8 + 3) * 129 + n]);
        o.z = pk_bf16(T[(ch * 8 + 4) * 129 + n], T[(ch * 8 + 5) * 129 + n]);
        o.w = pk_bf16(T[(ch * 8 + 6) * 129 + n], T[(ch * 8 + 7) * 129 + n]);
        *(u32x4*)((unsigned char*)w.dst + ((size_t)(w.n0 >> 7) * (w.K >> 6) + (w.k0 >> 6)) * 16384 + pg8::lds_byte(n, ch * 8)) = o;
    }
    __syncthreads();
}

__device__ __forceinline__ void phase_prep(const Params& p, unsigned char* smem) {
    float* T = (float*)smem;
    const int bid = blockIdx.x, nb = gridDim.x, tid = threadIdx.x;
    unsigned char* ws = p.ws;
    {
        constexpr int NT = 32 * 50 + 32 * 16 + 32 * 88 + 88 * 16;
        f32x4 va[4], vb[4];
        int t = bid;
        if (t < NT) wt_load(wt_decode(p, t), va);
        while (t < NT) {
            const int tn = t + nb;
            if (tn < NT) wt_load(wt_decode(p, tn), vb);
            wt_store(wt_decode(p, t), va, T);
#pragma unroll
            for (int q = 0; q < 4; ++q) va[q] = vb[q];
            t = tn;
        }
    }
    {
        const int wave = tid >> 6, lane = tid & 63;
        bf16_t* xb = (bf16_t*)(ws + W_XB); float* rstd1 = (float*)(ws + W_RSTD1);
        for (int row = bid * 8 + wave; row < MPAD; row += nb * 8) {
            if (row < NTOK) {
                const float* xr = row < NTP ? p.in[0] + (size_t)row * DM : p.in[1] + (size_t)(row - NTP) * DM;
                float s = 0.f;
#pragma unroll
                for (int q = 0; q < 8; ++q) {
                    const f32x4 v = *(const f32x4*)(xr + (q * 64 + lane) * 4);
                    s += v[0] * v[0] + v[1] * v[1] + v[2] * v[2] + v[3] * v[3];
                    u32x2 w; w.x = pk_bf16(v[0], v[1]); w.y = pk_bf16(v[2], v[3]);
                    *(u32x2*)(xb + (size_t)row * DM + (q * 64 + lane) * 4) = w;
                }
#pragma unroll
                for (int o = 32; o >= 1; o >>= 1) s += __shfl_xor(s, o);
                if (lane == 0) rstd1[row] = rsqrtf(s * (1.0f / DM) + EPS);
            } else {
#pragma unroll
                for (int q = 0; q < 8; ++q) *(u32x2*)(xb + (size_t)row * DM + (q * 64 + lane) * 4) = (u32x2){0u, 0u};
                if (lane == 0) rstd1[row] = 0.f;
            }
        }
    }
    {
        float* ss2 = (float*)(ws + W_SS2); float* ss3 = (float*)(ws + W_SS3);
        for (int i = bid * NTHR + tid; i < MPAD; i += nb * NTHR) { ss2[i] = 0.f; ss3[i] = 0.f; }
        if (bid == 0 && tid < 64) ((unsigned*)(ws + W_CTL))[tid] = 0u;
        if (bid == 1 && tid < 128) ((unsigned*)(ws + W_CNT))[tid] = 0u;
    }
}

__device__ __forceinline__ void gla_prep_item(const Params& p, unsigned char* smem, int item) {
    const int tid = threadIdx.x, wave = tid >> 6, lane = tid & 63, l15 = lane & 15, quad = lane >> 4;
    const int n = item & 63, h = (item >> 6) & 3, b = item >> 8;
    const bf16_t* proj = (const bf16_t*)(p.ws + W_PROJ);
    const float* zab = (const float*)(p.ws + W_ZA);
    float* oraw = (float*)(p.ws + W_OARAW);
    bf16_t* QD = (bf16_t*)(p.ws + W_QD); bf16_t* KT = (bf16_t*)(p.ws + W_KT); bf16_t* VT = (bf16_t*)(p.ws + W_VT); float* ET = (float*)(p.ws + W_ET);
    bf16_t* qd = (bf16_t*)(smem);
    bf16_t* kd = (bf16_t*)(smem + 17408);
    unsigned char* vimg = smem + 34816;
    bf16_t* attn = (bf16_t*)(smem + 69632);
    float* zas = (float*)(smem + 78848);
    float* gsum = (float*)(smem + 82944);
    const int c = tid & 127, tg = tid >> 7;
    float wg[16];
#pragma unroll
    for (int r = 0; r < 16; ++r) wg[r] = p.in[8][r * 512 + h * 128 + c];
    const float bg = p.in[9][h * 128 + c];
    const float qscale = 0.08838834764831845f;
    const size_t tok0 = (size_t)b * SEQ + n * 64;
    if (tid < 256) *(f32x4*)(zas + tid * 4) = *(const f32x4*)(zab + tok0 * 16 + tid * 4);
#pragma unroll
    for (int q = 0; q < 4; ++q) {
        const int idx = tid + q * 512, t = idx >> 5, ch = idx & 31;
        *(u32x4*)(vimg + t * 544 + ch * 16) = *(const u32x4*)(proj + (tok0 + t) * NIN + C_VA + h * 256 + ch * 8);
    }
    float qv[16], kv[16];
#pragma unroll
    for (int i = 0; i < 16; ++i) {
        const bf16_t* pr = proj + (tok0 + tg * 16 + i) * NIN + h * 128 + c;
        qv[i] = bf2f(pr[C_QA]) * qscale; kv[i] = bf2f(pr[C_KA]);
    }
    __syncthreads();
    float cl[16]; float run = 0.f;
#pragma unroll
    for (int i = 0; i < 16; ++i) {
        const int t = tg * 16 + i; float z = bg;
#pragma unroll
        for (int r = 0; r < 16; ++r) z += zas[t * 16 + r] * wg[r];
        run += logsigmoidf(z) * (1.0f / 16.0f); cl[i] = run;
    }
    gsum[tg * 128 + c] = run;
    __syncthreads();
    float off = 0.f, total = 0.f;
#pragma unroll
    for (int g = 0; g < 4; ++g) { const float v = gsum[g * 128 + c]; total += v; if (g < tg) off += v; }
    const float etot = __expf(total);
    if (tid < 128) ET[(size_t)item * 128 + c] = etot;
    unsigned ktw[8];
#pragma unroll
    for (int i = 0; i < 16; i += 2) {
        const float cum0 = off + cl[i], cum1 = off + cl[i + 1];
        const float e0 = __expf(cum0), e1 = __expf(cum1), r0 = __builtin_amdgcn_rcpf(e0), r1 = __builtin_amdgcn_rcpf(e1);
        const bf16_t q0 = f2bf(qv[i] * e0), q1 = f2bf(qv[i + 1] * e1);
        const int t = tg * 16 + i;
        qd[t * 136 + c] = q0; qd[(t + 1) * 136 + c] = q1;
        QD[(tok0 + t) * 512 + h * 128 + c] = q0; QD[(tok0 + t + 1) * 512 + h * 128 + c] = q1;
        kd[t * 136 + c] = f2bf(kv[i] * r0); kd[(t + 1) * 136 + c] = f2bf(kv[i + 1] * r1);
        ktw[i >> 1] = pk_bf16(kv[i] * (etot * r0), kv[i + 1] * (etot * r1));
    }
    {
        bf16_t* kt = KT + ((size_t)item * 128 + c) * 64 + tg * 16;
        *(u32x4*)(kt) = (u32x4){ktw[0], ktw[1], ktw[2], ktw[3]};
        *(u32x4*)(kt + 8) = (u32x4){ktw[4], ktw[5], ktw[6], ktw[7]};
    }
    __syncthreads();
    const int tt = wave >> 1;
#pragma unroll
    for (int e = 0; e < 2; ++e) {
        const int ss = (wave & 1) * 2 + e;
        f32x4 a = {0.f, 0.f, 0.f, 0.f};
        if (ss <= tt) {
#pragma unroll
            for (int ks = 0; ks < 4; ++ks) {
                const bf16x8 A = *(const bf16x8*)(qd + (16 * tt + l15) * 136 + 32 * ks + 8 * quad);
                const bf16x8 B = *(const bf16x8*)(kd + (16 * ss + l15) * 136 + 32 * ks + 8 * quad);
                a = __builtin_amdgcn_mfma_f32_16x16x32_bf16(A, B, a, 0, 0, 0);
            }
        }
#pragma unroll
        for (int j = 0; j < 4; ++j) {
            const int tr = 16 * tt + quad * 4 + j, sc = 16 * ss + l15;
            attn[tr * 72 + sc] = f2bf(sc <= tr ? a[j] : 0.f);
        }
    }
    {
        const unsigned vb = (unsigned)(size_t)vimg;
#pragma unroll
        for (int e = 0; e < 4; ++e) {
            const int pid = (wave * 4 + e) * 4 + quad, sp = pid & 7, db = pid >> 3;
            const unsigned a0 = vb + (unsigned)((8 * sp + (l15 >> 2)) * 544 + (16 * db + 4 * (l15 & 3)) * 2);
            s16x4 lo, hi;
            asm volatile("ds_read_b64_tr_b16 %0, %2\n\tds_read_b64_tr_b16 %1, %2 offset:2176\n\ts_waitcnt lgkmcnt(0)" : "=&v"(lo), "=&v"(hi) : "v"(a0) : "memory");
            *(bf16x8*)(VT + ((size_t)item * 256 + 16 * db + l15) * 64 + 8 * sp) = __builtin_shufflevector(lo, hi, 0, 1, 2, 3, 4, 5, 6, 7);
        }
    }
    __syncthreads();
    {
        const unsigned vb = (unsigned)(size_t)vimg + (unsigned)((8 * quad + (l15 >> 2)) * 544 + ((wave & 1) * 128 + 4 * (l15 & 3)) * 2);
        f32x4 o[8];
#pragma unroll
        for (int e = 0; e < 8; ++e) o[e] = (f32x4){0.f, 0.f, 0.f, 0.f};
#pragma unroll
        for (int ks = 0; ks < 2; ++ks) {
            const bf16x8 A = *(const bf16x8*)(attn + (16 * tt + l15) * 72 + 32 * ks + 8 * quad);
            s16x4 lo[8], hi[8];
            const unsigned va = vb + ks * 32 * 544;
            asm volatile(
                "ds_read_b64_tr_b16 %0, %16 offset:0\n\tds_read_b64_tr_b16 %1, %16 offset:32\n\tds_read_b64_tr_b16 %2, %16 offset:64\n\tds_read_b64_tr_b16 %3, %16 offset:96\n\t"
                "ds_read_b64_tr_b16 %4, %16 offset:128\n\tds_read_b64_tr_b16 %5, %16 offset:160\n\tds_read_b64_tr_b16 %6, %16 offset:192\n\tds_read_b64_tr_b16 %7, %16 offset:224\n\t"
                "ds_read_b64_tr_b16 %8, %16 offset:2176\n\tds_read_b64_tr_b16 %9, %16 offset:2208\n\tds_read_b64_tr_b16 %10, %16 offset:2240\n\tds_read_b64_tr_b16 %11, %16 offset:2272\n\t"
                "ds_read_b64_tr_b16 %12, %16 offset:2304\n\tds_read_b64_tr_b16 %13, %16 offset:2336\n\tds_read_b64_tr_b16 %14, %16 offset:2368\n\tds_read_b64_tr_b16 %15, %16 offset:2400\n\t"
                "s_waitcnt lgkmcnt(0)"
                : "=&v"(lo[0]), "=&v"(lo[1]), "=&v"(lo[2]), "=&v"(lo[3]), "=&v"(lo[4]), "=&v"(lo[5]), "=&v"(lo[6]), "=&v"(lo[7]),
                  "=&v"(hi[0]), "=&v"(hi[1]), "=&v"(hi[2]), "=&v"(hi[3]), "=&v"(hi[4]), "=&v"(hi[5]), "=&v"(hi[6]), "=&v"(hi[7])
                : "v"(va) : "memory");
#pragma unroll
            for (int e = 0; e < 8; ++e) {
                const bf16x8 B = __builtin_shufflevector(lo[e], hi[e], 0, 1, 2, 3, 4, 5, 6, 7);
                o[e] = __builtin_amdgcn_mfma_f32_16x16x32_bf16(B, A, o[e], 0, 0, 0);
            }
        }
#pragma unroll
        for (int e = 0; e < 8; ++e) *(f32x4*)(oraw + (tok0 + 16 * tt + l15) * 1024 + h * 256 + ((wave & 1) * 8 + e) * 16 + quad * 4) = o[e];
    }
    asm volatile("s_waitcnt vmcnt(0)" ::: "memory");
    __syncthreads();
}

constexpr int GS_KT = 0, GS_QD = 18432, GS_ET = 18432 + 17408, GS_BUF = 36352;
__device__ __forceinline__ void gla_seq_item(const Params& p, unsigned char* smem, int item) {
    const int tid = threadIdx.x, wave = tid >> 6, lane = tid & 63, l15 = lane & 15, quad = lane >> 4;
    const int half = item & 1, h = (item >> 1) & 3, b = item >> 3;
    const int dv0 = (half * 8 + wave) * 16;
    const bf16_t* QD = (const bf16_t*)(p.ws + W_QD); const bf16_t* KT = (const bf16_t*)(p.ws + W_KT); const bf16_t* VT = (const bf16_t*)(p.ws + W_VT);
    const float* ET = (const float*)(p.ws + W_ET); float* OI = (float*)(p.ws + W_OI);
    auto wait_group = [&](int g8) {
        if (tid == 0) {
            unsigned* cnt = (unsigned*)(p.ws + W_CNT) + (b * 4 + h) * 8 + g8;
            unsigned sp = 0;
            while (__hip_atomic_load(cnt, __ATOMIC_RELAXED, __HIP_MEMORY_SCOPE_AGENT) < 8u && ++sp < (1u << 20)) __builtin_amdgcn_s_sleep(8);
            __builtin_amdgcn_fence(__ATOMIC_ACQUIRE, "agent");
            asm volatile("s_waitcnt vmcnt(0)" ::: "memory");
        }
        __syncthreads();
    };
    wait_group(0);
    f32x4 S[8];
#pragma unroll
    for (int ct = 0; ct < 8; ++ct) S[ct] = (f32x4){0.f, 0.f, 0.f, 0.f};
    struct GSet { u32x4 k[2], q[2]; float e; bf16x8 v[2]; };
    const size_t ci0 = (size_t)(b * 4 + h) * 64, tokb = (size_t)b * SEQ;
    auto issue = [&](int n, GSet& s) {
        const size_t ci = ci0 + n, tok0 = tokb + (size_t)n * 64;
#pragma unroll
        for (int q = 0; q < 2; ++q) {
            const int idx = tid + q * 512;
            s.k[q] = *(const u32x4*)(KT + (ci * 128 + (idx >> 3)) * 64 + (idx & 7) * 8);
            s.q[q] = *(const u32x4*)(QD + (tok0 + (idx >> 4)) * 512 + h * 128 + (idx & 15) * 8);
        }
        s.e = 0.f; if (tid < 128) s.e = ET[ci * 128 + tid];
#pragma unroll
        for (int ks = 0; ks < 2; ++ks) s.v[ks] = *(const bf16x8*)(VT + (ci * 256 + dv0 + l15) * 64 + 32 * ks + 8 * quad);
    };
    auto stash = [&](int buf, const GSet& s) {
        unsigned char* B = smem + buf * GS_BUF;
#pragma unroll
        for (int q = 0; q < 2; ++q) {
            const int idx = tid + q * 512;
            *(u32x4*)(B + GS_KT + (idx >> 3) * 144 + (idx & 7) * 16) = s.k[q];
            *(u32x4*)(B + GS_QD + (idx >> 4) * 272 + (idx & 15) * 16) = s.q[q];
        }
        if (tid < 128) ((float*)(B + GS_ET))[tid] = s.e;
    };
    bf16x8 vt[2];
    auto step = [&](int n, GSet& sa, GSet& sb) {
        const size_t tok0 = tokb + (size_t)n * 64;
        if (n + 2 < 64 && ((n + 2) & 7) == 0) wait_group((n + 2) >> 3);
        if (n + 2 < 64) issue(n + 2, sb);
        const unsigned char* B = smem + (n & 1) * GS_BUF;
        bf16x8 Sp[4];
#pragma unroll
        for (int ks = 0; ks < 4; ++ks) {
            u32x4 w; w.x = pk_bf16(S[2 * ks][0], S[2 * ks][1]); w.y = pk_bf16(S[2 * ks][2], S[2 * ks][3]);
            w.z = pk_bf16(S[2 * ks + 1][0], S[2 * ks + 1][1]); w.w = pk_bf16(S[2 * ks + 1][2], S[2 * ks + 1][3]);
            Sp[ks] = __builtin_bit_cast(bf16x8, w);
        }
#pragma unroll
        for (int tt = 0; tt < 4; ++tt) {
            f32x4 o = {0.f, 0.f, 0.f, 0.f};
            const unsigned char* qr = B + GS_QD + (16 * tt + l15) * 272 + 8 * quad;
#pragma unroll
            for (int ks = 0; ks < 4; ++ks) {
                const u32x2 lo = *(const u32x2*)(qr + 64 * ks), hi = *(const u32x2*)(qr + 64 * ks + 32);
                const u32x4 w = {lo.x, lo.y, hi.x, hi.y};
                o = __builtin_amdgcn_mfma_f32_16x16x32_bf16(Sp[ks], __builtin_bit_cast(bf16x8, w), o, 0, 0, 0);
            }
            *(f32x4*)(OI + (tok0 + 16 * tt + l15) * 1024 + h * 256 + dv0 + 4 * quad) = o;
        }
#pragma unroll
        for (int ct = 0; ct < 8; ++ct) {
            const f32x4 et = *(const f32x4*)(B + GS_ET + (16 * ct + 4 * quad) * 4);
            S[ct] = S[ct] * et;
#pragma unroll
            for (int ks = 0; ks < 2; ++ks) {
                const bf16x8 A = *(const bf16x8*)(B + GS_KT + (16 * ct + l15) * 144 + (32 * ks + 8 * quad) * 2);
                S[ct] = __builtin_amdgcn_mfma_f32_16x16x32_bf16(A, vt[ks], S[ct], 0, 0, 0);
            }
        }
        if (n + 1 < 64) { stash((n + 1) & 1, sa); vt[0] = sa.v[0]; vt[1] = sa.v[1]; }
        __syncthreads();
    };
    GSet g0, g1;
    issue(0, g0); stash(0, g0); vt[0] = g0.v[0]; vt[1] = g0.v[1];
    __syncthreads();
    issue(1, g0);
    for (int n = 0; n < 64; n += 2) { step(n, g0, g1); step(n + 1, g1, g0); }
    float* sg = p.out + O_SGP + ((size_t)(b * 4 + h) * 128) * 256 + dv0 + l15;
#pragma unroll
    for (int ct = 0; ct < 8; ++ct)
#pragma unroll
        for (int j = 0; j < 4; ++j) sg[(size_t)(16 * ct + 4 * quad + j) * 256] = S[ct][j];
}

__device__ __forceinline__ void gla_sample_item(const Params& p, unsigned char* smem, int item) {
    const int tid = threadIdx.x;
    const int h = item & 3, s = item >> 2;
    const bf16_t* proj = (const bf16_t*)(p.ws + W_PROJ);
    const float* zab = (const float*)(p.ws + W_ZA);
    float* oraw = (float*)(p.ws + W_OARAW);
    float* la = (float*)smem;
    float* qs = la + 512;
    float* ks_ = qs + 512;
    float* vs_ = ks_ + 512;
    float* red = vs_ + 1024;
    const size_t row0 = (size_t)NTP + s * 4;
    {
        const int c = tid & 127, i = tid >> 7;
        float z = p.in[9][h * 128 + c];
#pragma unroll
        for (int r = 0; r < 16; ++r) z += zab[(row0 + i) * 16 + r] * p.in[8][r * 512 + h * 128 + c];
        la[i * 128 + c] = __expf(logsigmoidf(z) * (1.0f / 16.0f));
        const bf16_t* pr = proj + (row0 + i) * NIN + h * 128 + c;
        qs[i * 128 + c] = bf2f(pr[C_QA]) * 0.08838834764831845f;
        ks_[i * 128 + c] = bf2f(pr[C_KA]);
        for (int e = tid; e < 1024; e += NTHR) { const int ii = e >> 8, dv = e & 255; vs_[e] = bf2f(proj[(row0 + ii) * NIN + C_VA + h * 256 + dv]); }
    }
    __syncthreads();
    const int dv = tid & 255, ch = tid >> 8;
    const float* s0 = p.in[2] + ((size_t)(s * 4 + h) * 128 + ch * 64) * 256 + dv;
    float S[64];
#pragma unroll
    for (int cc = 0; cc < 64; ++cc) S[cc] = s0[(size_t)cc * 256];
#pragma unroll
    for (int i = 0; i < 4; ++i) {
        const float v = vs_[i * 256 + dv]; float o = 0.f;
#pragma unroll
        for (int cc = 0; cc < 64; ++cc) {
            const int c = ch * 64 + cc;
            S[cc] = la[i * 128 + c] * S[cc] + ks_[i * 128 + c] * v;
            o += qs[i * 128 + c] * S[cc];
        }
        red[(i * 2 + ch) * 256 + dv] = o;
    }
    float* so = p.out + O_SGS + ((size_t)(s * 4 + h) * 128 + ch * 64) * 256 + dv;
#pragma unroll
    for (int cc = 0; cc < 64; ++cc) so[(size_t)cc * 256] = S[cc];
    __syncthreads();
    for (int e = tid; e < 1024; e += NTHR) { const int i = e >> 8, d = e & 255; oraw[(row0 + i) * 1024 + h * 256 + d] = red[(i * 2) * 256 + d] + red[(i * 2 + 1) * 256 + d]; }
    __syncthreads();
}

__device__ __forceinline__ void swa_sample_item(const Params& p, unsigned char* smem, int item) {
    const int tid = threadIdx.x, wave = tid >> 6, lane = tid & 63, sub = lane & 15, grp = lane >> 4;
    const int h = item & 7, s = item >> 3;
    const int i = wave & 3, hf = wave >> 2;
    const int kk0 = hf * 196, kk1 = hf ? 387 : 196;
    const bf16_t* proj = (const bf16_t*)(p.ws + W_PROJ);
    float* sc = (float*)smem + wave * 200;
    float* mrg = (float*)smem + 1600;
    const size_t rowq = (size_t)NTP + s * 4 + i;
    float q[8];
    { const u32x4 w = *(const u32x4*)(proj + rowq * NIN + C_QB + h * 128 + sub * 8);
      q[0] = bflo(w.x); q[1] = bfhi(w.x); q[2] = bflo(w.y); q[3] = bfhi(w.y); q[4] = bflo(w.z); q[5] = bfhi(w.z); q[6] = bflo(w.w); q[7] = bfhi(w.w); }
    const float slope = exp2f(-(float)(h + 1));
    const float* ck = p.in[3] + (size_t)s * 2048 * 1024 + h * 128;
    const float* cv = p.in[4] + (size_t)s * 2048 * 1024 + h * 128;
    const bf16_t* nk = proj + ((size_t)NTP + s * 4) * NIN + C_KB + h * 128;
    const bf16_t* nv = proj + ((size_t)NTP + s * 4) * NIN + C_VB + h * 128;
    for (int it0 = 0; it0 < 52; it0 += 13) {
        float kvv[13][8]; float bias[13];
#pragma unroll
        for (int u = 0; u < 13; ++u) {
            int kk = kk0 + (it0 + u) * 4 + grp; if (kk >= kk1) kk = kk1 - 1;
            const int g = kk / 129, j = kk - g * 129, dil = 1 << (2 * g);
            const int idx = 2048 + i - dil * j;
            bias[u] = slope * (float)(dil * j);
            if (idx < 2048) {
                const f32x4 a = *(const f32x4*)(ck + (size_t)idx * 1024 + sub * 8), b2 = *(const f32x4*)(ck + (size_t)idx * 1024 + sub * 8 + 4);
                kvv[u][0] = a[0]; kvv[u][1] = a[1]; kvv[u][2] = a[2]; kvv[u][3] = a[3]; kvv[u][4] = b2[0]; kvv[u][5] = b2[1]; kvv[u][6] = b2[2]; kvv[u][7] = b2[3];
            } else {
                const u32x4 w = *(const u32x4*)(nk + (size_t)(idx - 2048) * NIN + sub * 8);
                kvv[u][0] = bflo(w.x); kvv[u][1] = bfhi(w.x); kvv[u][2] = bflo(w.y); kvv[u][3] = bfhi(w.y); kvv[u][4] = bflo(w.z); kvv[u][5] = bfhi(w.z); kvv[u][6] = bflo(w.w); kvv[u][7] = bfhi(w.w);
            }
        }
#pragma unroll
        for (int u = 0; u < 13; ++u) {
            float d = 0.f;
#pragma unroll
            for (int e = 0; e < 8; ++e) d += q[e] * kvv[u][e];
            d += __shfl_xor(d, 1); d += __shfl_xor(d, 2); d += __shfl_xor(d, 4); d += __shfl_xor(d, 8);
            const int kl = (it0 + u) * 4 + grp;
            if (sub == 0 && kl < 196) sc[kl] = (kk0 + kl < kk1) ? d * 0.08838834764831845f - bias[u] : -1e30f;
        }
    }
    __builtin_amdgcn_s_waitcnt(0);
    __builtin_amdgcn_wave_barrier();
    float mx = -1e30f;
    for (int kl = lane; kl < 196; kl += 64) mx = fmaxf(mx, sc[kl]);
#pragma unroll
    for (int o = 32; o >= 1; o >>= 1) mx = fmaxf(mx, __shfl_xor(mx, o));
    float l = 0.f;
    for (int kl = lane; kl < 196; kl += 64) { const float sv = sc[kl]; const float e = sv > -1e29f ? __expf(sv - mx) : 0.f; sc[kl] = e; l += e; }
#pragma unroll
    for (int o = 32; o >= 1; o >>= 1) l += __shfl_xor(l, o);
    __builtin_amdgcn_s_waitcnt(0);
    __builtin_amdgcn_wave_barrier();
    float o0 = 0.f, o1 = 0.f;
    for (int kb = 0; kb < 196; kb += 28) {
        float v0[28], v1[28], pw[28];
#pragma unroll
        for (int u = 0; u < 28; ++u) {
            int kk = kk0 + kb + u; if (kk >= kk1) kk = kk1 - 1;
            const int g = kk / 129, j = kk - g * 129, dil = 1 << (2 * g);
            const int idx = 2048 + i - dil * j;
            pw[u] = sc[kb + u];
            if (idx < 2048) { const f32x2 v = *(const f32x2*)(cv + (size_t)idx * 1024 + lane * 2); v0[u] = v[0]; v1[u] = v[1]; }
            else { const unsigned w = *(const unsigned*)(nv + (size_t)(idx - 2048) * NIN + lane * 2); v0[u] = bflo(w); v1[u] = bfhi(w); }
        }
#pragma unroll
        for (int u = 0; u < 28; ++u) { o0 += pw[u] * v0[u]; o1 += pw[u] * v1[u]; }
    }
    if (hf == 1) { mrg[i * 132 + lane * 2] = o0; mrg[i * 132 + lane * 2 + 1] = o1; if (lane == 0) { mrg[i * 132 + 128] = mx; mrg[i * 132 + 129] = l; } }
    __syncthreads();
    if (hf == 0) {
        const float m1 = mrg[i * 132 + 128], l1 = mrg[i * 132 + 129];
        const float mm = fmaxf(mx, m1), e0 = __expf(mx - mm), e1 = __expf(m1 - mm);
        const float inv = 1.0f / (l * e0 + l1 * e1);
        const float r0 = (o0 * e0 + mrg[i * 132 + lane * 2] * e1) * inv, r1 = (o1 * e0 + mrg[i * 132 + lane * 2 + 1] * e1) * inv;
        bf16_t* mix = (bf16_t*)(p.ws + W_MIX);
        *(unsigned*)(mix + rowq * DM + 1024 + h * 128 + lane * 2) = pk_bf16(r0, r1);
    }
    __syncthreads();
}

__device__ __forceinline__ void copy_item(const Params& p, int item) {
    const int which = item >> 9, b = (item >> 4) & 31, piece = item & 15;
    constexpr int PIECE = 32704;
    const f32x4* src = (const f32x4*)(p.in[3 + which] + (size_t)b * 2048 * 1024 + 4096) + (size_t)piece * PIECE;
    f32x4* dst = (f32x4*)(p.out + (which ? O_CVS : O_CKS) + (size_t)b * 2048 * 1024) + (size_t)piece * PIECE;
    const int tid = threadIdx.x;
    for (int j0 = 0; j0 < 64; j0 += 32) {
        f32x4 v[32];
#pragma unroll
        for (int u = 0; u < 32; ++u) { const int idx = tid + (j0 + u) * 512; if (idx < PIECE) v[u] = __builtin_nontemporal_load(src + idx); }
#pragma unroll
        for (int u = 0; u < 32; ++u) { const int idx = tid + (j0 + u) * 512; if (idx < PIECE) __builtin_nontemporal_store(v[u], dst + idx); }
    }
}
constexpr int NCOPY = 1024;
__device__ __forceinline__ void copy_worker(const Params& p, unsigned char* smem, int phase_slot, int ngemm) {
    unsigned* ctl = (unsigned*)(p.ws + W_CTL);
    int* slot = (int*)(smem + LDS_BYTES - 16);
    for (;;) {
        if (threadIdx.x == 0) {
            int q = NCOPY;
            if (ngemm == 0 || (int)__hip_atomic_load(ctl + 33 + phase_slot, __ATOMIC_RELAXED, __HIP_MEMORY_SCOPE_AGENT) < ngemm) q = (int)atomicAdd(ctl + 32, 1u);
            *slot = q;
        }
        __syncthreads();
        const int q = *slot;
        __syncthreads();
        if (q >= NCOPY) break;
        copy_item(p, q);
    }
}
__device__ __forceinline__ void gemm_done(const Params& p, int phase_slot) {
    if (threadIdx.x == 0) atomicAdd((unsigned*)(p.ws + W_CTL) + 33 + phase_slot, 1u);
}

constexpr int KPITCH = 272, VPITCH = 288, KIMG = 0, VIMG = 272 * 272;
struct SwaItem { int g, b, h, dil, res, ib; };
__device__ __forceinline__ SwaItem swa_decode(int item) {
    SwaItem s; const int bh = item / 96, r96 = item - bh * 96; s.g = r96 >> 5; s.b = bh >> 3; s.h = bh & 7; const int blk = r96 & 31;
    s.dil = 1 << (2 * s.g); const int nblk = 32 >> (2 * s.g); s.res = blk / nblk; s.ib = blk % nblk; return s;
}
__device__ __forceinline__ void swa_issue(const Params& p, int item, u32x4 (&kr)[9], u32x4 (&vr)[9], bf16x8 (&Qf)[4]) {
    const int tid = threadIdx.x, wave = tid >> 6, lane = tid & 63, l15 = lane & 15, quad = lane >> 4;
    const SwaItem s = swa_decode(item);
    const bf16_t* proj = (const bf16_t*)(p.ws + W_PROJ);
    const size_t rowb = (size_t)s.b * SEQ;
    const int kp0 = 128 * (s.ib - 1) - 16;
#pragma unroll
    for (int q = 0; q < 9; ++q) {
        const int idx = tid + q * 512, lr = idx >> 4, ch = idx & 15, kp = kp0 + lr;
        kr[q] = (u32x4){0u, 0u, 0u, 0u}; vr[q] = (u32x4){0u, 0u, 0u, 0u};
        if (kp >= 0 && lr < 272) {
            const size_t off = ((size_t)(s.b * 8 + s.h) * SEQ + (size_t)kp * s.dil + s.res) * 128 + ch * 8;
            kr[q] = *(const u32x4*)((const bf16_t*)(p.ws + W_KC) + off); vr[q] = *(const u32x4*)((const bf16_t*)(p.ws + W_VC) + off);
        }
    }
    const int qp = 128 * s.ib + 16 * wave + l15;
    const size_t qrow = rowb + (size_t)qp * s.dil + s.res;
#pragma unroll
    for (int ks = 0; ks < 4; ++ks) Qf[ks] = *(const bf16x8*)(proj + qrow * NIN + C_QB + s.h * 128 + 32 * ks + 8 * quad);
}
__device__ __forceinline__ void swa_stash(unsigned char* smem, const u32x4 (&kr)[9], const u32x4 (&vr)[9]) {
    const int tid = threadIdx.x;
#pragma unroll
    for (int q = 0; q < 9; ++q) {
        const int idx = tid + q * 512, lr = idx >> 4, ch = idx & 15;
        if (lr < 272) { *(u32x4*)(smem + KIMG + lr * KPITCH + ch * 16) = kr[q]; *(u32x4*)(smem + VIMG + lr * VPITCH + ch * 16) = vr[q]; }
    }
}
__device__ __forceinline__ void swa_compute(const Params& p, unsigned char* smem, int item, const bf16x8 (&Qf)[4]) {
    const int tid = threadIdx.x, wave = tid >> 6, lane = tid & 63, l15 = lane & 15, quad = lane >> 4;
    const SwaItem s = swa_decode(item);
    const int g = s.g, h = s.h, dil = s.dil, ib = s.ib;
    const size_t rowb = (size_t)s.b * SEQ;
    const int kp0 = 128 * (ib - 1) - 16;
    const int qp = 128 * ib + 16 * wave + l15;
    const size_t qrow = rowb + (size_t)qp * dil + s.res;
    const float SC2 = 0.08838834764831845f * 1.4426950408889634f;
    const float SL2 = exp2f(-(float)(h + 1)) * (float)dil * 1.4426950408889634f;
    f32x4 O[8];
#pragma unroll
    for (int dt = 0; dt < 8; ++dt) O[dt] = (f32x4){0.f, 0.f, 0.f, 0.f};
    float mrun = -1e30f, lrun = 0.f;
    const unsigned vbase = (unsigned)(size_t)(smem + VIMG);
    for (int pr = 0; pr < 5; ++pr) {
        const int lrb = 16 * wave + 32 * pr, kpb = kp0 + lrb;
        if (kpb + 31 < 0) continue;
        f32x4 sacc[2];
#pragma unroll
        for (int T = 0; T < 2; ++T) {
            sacc[T] = (f32x4){0.f, 0.f, 0.f, 0.f};
#pragma unroll
            for (int ks = 0; ks < 4; ++ks) {
                const bf16x8 A = *(const bf16x8*)(smem + KIMG + (lrb + 16 * T + l15) * KPITCH + (32 * ks + 8 * quad) * 2);
                sacc[T] = __builtin_amdgcn_mfma_f32_16x16x32_bf16(A, Qf[ks], sacc[T], 0, 0, 0);
            }
        }
        s16x4 lo[8], hi[8];
        {
            const unsigned va = vbase + (unsigned)((lrb + quad * 4 + (l15 >> 2)) * VPITCH + (4 * (l15 & 3)) * 2);
            asm volatile(
                "ds_read_b64_tr_b16 %0, %16 offset:0\n\tds_read_b64_tr_b16 %1, %16 offset:32\n\tds_read_b64_tr_b16 %2, %16 offset:64\n\tds_read_b64_tr_b16 %3, %16 offset:96\n\t"
                "ds_read_b64_tr_b16 %4, %16 offset:128\n\tds_read_b64_tr_b16 %5, %16 offset:160\n\tds_read_b64_tr_b16 %6, %16 offset:192\n\tds_read_b64_tr_b16 %7, %16 offset:224\n\t"
                "ds_read_b64_tr_b16 %8, %16 offset:4608\n\tds_read_b64_tr_b16 %9, %16 offset:4640\n\tds_read_b64_tr_b16 %10, %16 offset:4672\n\tds_read_b64_tr_b16 %11, %16 offset:4704\n\t"
                "ds_read_b64_tr_b16 %12, %16 offset:4736\n\tds_read_b64_tr_b16 %13, %16 offset:4768\n\tds_read_b64_tr_b16 %14, %16 offset:4800\n\tds_read_b64_tr_b16 %15, %16 offset:4832\n\t"
                "s_waitcnt lgkmcnt(0)"
                : "=&v"(lo[0]), "=&v"(lo[1]), "=&v"(lo[2]), "=&v"(lo[3]), "=&v"(lo[4]), "=&v"(lo[5]), "=&v"(lo[6]), "=&v"(lo[7]),
                  "=&v"(hi[0]), "=&v"(hi[1]), "=&v"(hi[2]), "=&v"(hi[3]), "=&v"(hi[4]), "=&v"(hi[5]), "=&v"(hi[6]), "=&v"(hi[7])
                : "v"(va) : "memory");
        }
        float sv[8]; bool ok[8]; float mx = -1e30f;
#pragma unroll
        for (int T = 0; T < 2; ++T)
#pragma unroll
            for (int j = 0; j < 4; ++j) {
                const int kp = kpb + 16 * T + quad * 4 + j, dist = qp - kp;
                const bool v = (dist >= 0) && (dist <= 128) && (kp >= 0);
                const float s2 = sacc[T][j] * SC2 - SL2 * (float)dist;
                ok[T * 4 + j] = v; sv[T * 4 + j] = s2; if (v) mx = fmaxf(mx, s2);
            }
        mx = fmaxf(mx, __shfl_xor(mx, 16)); mx = fmaxf(mx, __shfl_xor(mx, 32));
        const float mnew = fmaxf(mrun, mx), alpha = __builtin_amdgcn_exp2f(mrun - mnew);
        mrun = mnew;
        float pv[8], ps = 0.f;
#pragma unroll
        for (int e = 0; e < 8; ++e) { pv[e] = ok[e] ? __builtin_amdgcn_exp2f(sv[e] - mnew) : 0.f; ps += pv[e]; }
        lrun = lrun * alpha + ps;
        u32x4 pw; pw.x = pk_bf16(pv[0], pv[1]); pw.y = pk_bf16(pv[2], pv[3]); pw.z = pk_bf16(pv[4], pv[5]); pw.w = pk_bf16(pv[6], pv[7]);
        const bf16x8 P = __builtin_bit_cast(bf16x8, pw);
#pragma unroll
        for (int dt = 0; dt < 8; ++dt) {
            const bf16x8 A = __builtin_shufflevector(lo[dt], hi[dt], 0, 1, 2, 3, 4, 5, 6, 7);
            O[dt] = O[dt] * alpha;
            O[dt] = __builtin_amdgcn_mfma_f32_16x16x32_bf16(A, P, O[dt], 0, 0, 0);
        }
    }
    lrun += __shfl_xor(lrun, 16); lrun += __shfl_xor(lrun, 32);
    const float inv = 1.0f / lrun;
    bf16_t* ob = (bf16_t*)(p.ws + W_OB3) + ((size_t)g * NTP + qrow) * 1024 + h * 128;
#pragma unroll
    for (int dt = 0; dt < 8; ++dt) {
        u32x2 w; w.x = pk_bf16(O[dt][0] * inv, O[dt][1] * inv); w.y = pk_bf16(O[dt][2] * inv, O[dt][3] * inv);
        *(u32x2*)(ob + 16 * dt + quad * 4) = w;
    }
    if (quad == 0) ((float*)(p.ws + W_LSE3))[((size_t)g * NTP + qrow) * 8 + h] = (mrun + log2f(lrun)) * 0.6931471805599453f;
}

__device__ __forceinline__ void phase_mix(const Params& p, unsigned char* smem) {
    const int tid = threadIdx.x;
    unsigned* qctr = (unsigned*)(p.ws + W_CTL);
    int* slot = (int*)(smem + LDS_BYTES - 16);
    int pending = -1;
    const bool seqwg = (int)blockIdx.x < 32;
    while (!seqwg) {
        if (tid == 0) {
            if (pending >= 0) {
                __builtin_amdgcn_fence(__ATOMIC_RELEASE, "agent");
                asm volatile("s_waitcnt vmcnt(0)" ::: "memory");
                __hip_atomic_fetch_add((unsigned*)(p.ws + W_CNT) + pending, 1u, __ATOMIC_RELAXED, __HIP_MEMORY_SCOPE_AGENT);
            }
            *slot = (int)atomicAdd(qctr, 1u);
        }
        __syncthreads();
        const int q = *slot;
        __syncthreads();
        if (q >= 1024) break;
        const int g8 = q >> 7, bh = (q >> 3) & 15, nn = g8 * 8 + (q & 7);
        gla_prep_item(p, smem, bh * 64 + nn);
        pending = bh * 8 + g8;
    }
    __syncthreads();
    if (seqwg) {
        gla_seq_item(p, smem, blockIdx.x);
    } else {
        for (;;) {
            if (tid == 0) *slot = (int)atomicAdd(qctr + 1, 1u);
            __syncthreads();
            const int q = *slot;
            __syncthreads();
            if (q >= 128) break;
            gla_sample_item(p, smem, q);
        }
        for (;;) {
            if (tid == 0) *slot = (int)atomicAdd(qctr + 2, 1u);
            __syncthreads();
            const int q = *slot;
            __syncthreads();
            if (q >= 256) break;
            swa_sample_item(p, smem, q);
        }
    }
    unsigned* qb = qctr + 16;
    if (tid == 0) *slot = (int)atomicAdd(qb, 1u);
    __syncthreads();
    int item = *slot;
    __syncthreads();
    u32x4 kr[9], vr[9]; bf16x8 Qf[4], Qn[4];
    if (item < 3072) swa_issue(p, item, kr, vr, Qf);
    while (item < 3072) {
        if (tid == 0) *slot = (int)atomicAdd(qb, 1u);
        swa_stash(smem, kr, vr);
        __syncthreads();
        const int next = *slot;
        if (next < 3072) swa_issue(p, next, kr, vr, Qn);
        swa_compute(p, smem, item, Qf);
        __syncthreads();
        item = next;
#pragma unroll
        for (int ks = 0; ks < 4; ++ks) Qf[ks] = Qn[ks];
    }
}

__device__ __forceinline__ void phase_combine(const Params& p) {
    const int tid = threadIdx.x, wave = tid >> 6, lane = tid & 63;
    const bf16_t* proj = (const bf16_t*)(p.ws + W_PROJ);
    const float* oraw = (const float*)(p.ws + W_OARAW);
    const bf16_t* ob3 = (const bf16_t*)(p.ws + W_OB3);
    const float* lse3 = (const float*)(p.ws + W_LSE3);
    bf16_t* mix = (bf16_t*)(p.ws + W_MIX);
    for (int row = blockIdx.x * 8 + wave; row < NTOK; row += gridDim.x * 8) {
        {
            const float* o = oraw + (size_t)row * 1024 + lane * 16;
            const float* o2 = (const float*)(p.ws + W_OI) + (size_t)row * 1024 + lane * 16;
            f32x4 v[4]; float s = 0.f;
#pragma unroll
            for (int q = 0; q < 4; ++q) { v[q] = *(const f32x4*)(o + q * 4); if (row < NTP) v[q] = v[q] + *(const f32x4*)(o2 + q * 4); s += v[q][0] * v[q][0] + v[q][1] * v[q][1] + v[q][2] * v[q][2] + v[q][3] * v[q][3]; }
            s += __shfl_xor(s, 1); s += __shfl_xor(s, 2); s += __shfl_xor(s, 4); s += __shfl_xor(s, 8);
            const float rs = rsqrtf(s * (1.0f / 256.0f) + EPS);
            const u32x4 g0 = *(const u32x4*)(proj + (size_t)row * NIN + C_GA + lane * 16), g1 = *(const u32x4*)(proj + (size_t)row * NIN + C_GA + lane * 16 + 8);
            const unsigned gw[8] = {g0.x, g0.y, g0.z, g0.w, g1.x, g1.y, g1.z, g1.w};
            unsigned ow[8];
#pragma unroll
            for (int e = 0; e < 8; ++e) {
                const float ga0 = bflo(gw[e]), ga1 = bfhi(gw[e]);
                const float x0 = v[e >> 1][(e & 1) * 2] * rs * p.in[10][lane * 16 + 2 * e] * siluf(ga0);
                const float x1 = v[e >> 1][(e & 1) * 2 + 1] * rs * p.in[10][lane * 16 + 2 * e + 1] * siluf(ga1);
                ow[e] = pk_bf16(x0, x1);
            }
            *(u32x4*)(mix + (size_t)row * DM + lane * 16) = (u32x4){ow[0], ow[1], ow[2], ow[3]};
            *(u32x4*)(mix + (size_t)row * DM + lane * 16 + 8) = (u32x4){ow[4], ow[5], ow[6], ow[7]};
        }
        if (row < NTP) {
            const int h = lane >> 3;
            const float l0 = lse3[((size_t)0 * NTP + row) * 8 + h], l1 = lse3[((size_t)1 * NTP + row) * 8 + h], l2 = lse3[((size_t)2 * NTP + row) * 8 + h];
            const float mx = fmaxf(l0, fmaxf(l1, l2));
            float w0 = __expf(l0 - mx), w1 = __expf(l1 - mx), w2 = __expf(l2 - mx);
            const float inv = 1.0f / (w0 + w1 + w2); w0 *= inv; w1 *= inv; w2 *= inv;
            unsigned ow[8];
            const u32x4* a0 = (const u32x4*)(ob3 + ((size_t)0 * NTP + row) * 1024 + lane * 16);
            const u32x4* a1 = (const u32x4*)(ob3 + ((size_t)1 * NTP + row) * 1024 + lane * 16);
            const u32x4* a2 = (const u32x4*)(ob3 + ((size_t)2 * NTP + row) * 1024 + lane * 16);
#pragma unroll
            for (int hh = 0; hh < 2; ++hh) {
                const u32x4 x0 = a0[hh], x1 = a1[hh], x2 = a2[hh];
#pragma unroll
                for (int e = 0; e < 4; ++e) {
                    const float lo = w0 * bflo(x0[e]) + w1 * bflo(x1[e]) + w2 * bflo(x2[e]);
                    const float hi = w0 * bfhi(x0[e]) + w1 * bfhi(x1[e]) + w2 * bfhi(x2[e]);
                    ow[hh * 4 + e] = pk_bf16(lo, hi);
                }
            }
            *(u32x4*)(mix + (size_t)row * DM + 1024 + lane * 16) = (u32x4){ow[0], ow[1], ow[2], ow[3]};
            *(u32x4*)(mix + (size_t)row * DM + 1024 + lane * 16 + 8) = (u32x4){ow[4], ow[5], ow[6], ow[7]};
        }
    }
}

__device__ __forceinline__ void phase_convgate(const Params& p) {
    const bf16_t* U = (const bf16_t*)(p.ws + W_U);
    bf16_t* act = (bf16_t*)(p.ws + W_ACT);
    const float* wc = p.in[14]; const float* bc = p.in[15]; const float* cs = p.in[5];
    for (int i = blockIdx.x * NTHR + threadIdx.x; i < NTS * DM / 4; i += gridDim.x * NTHR)
        ((f32x4*)(p.out + O_YS))[i] = ((const f32x4*)((const float*)(p.ws + W_H) + (size_t)NTP * DM))[i];
    constexpr int NCG = DFF / 8;
    constexpr int NROW = 512 + NTS;
    const int total = NCG * NROW;
    for (int uid = blockIdx.x * NTHR + threadIdx.x; uid < total; uid += gridDim.x * NTHR) {
        const int ridx = uid / NCG, j0 = (uid % NCG) * 8;
        const int r = ridx < 512 ? 64 * (ridx >> 1) + (ridx & 1) : NTP + (ridx - 512);
        const int uc = 256 * (j0 >> 7) + (j0 & 127);
        float ca[8], cv[8], h1a[8], h1v[8], h2a[8], h2v[8];
        auto ldrow = [&](size_t row, float* a, float* v) {
            const u32x4 x = *(const u32x4*)(U + row * NUP + uc), y = *(const u32x4*)(U + row * NUP + uc + 128);
#pragma unroll
            for (int e = 0; e < 4; ++e) { a[2 * e] = bflo(x[e]); a[2 * e + 1] = bfhi(x[e]); v[2 * e] = bflo(y[e]); v[2 * e + 1] = bfhi(y[e]); }
        };
        auto zero = [&](float* a, float* v) {
#pragma unroll
            for (int e = 0; e < 8; ++e) { a[e] = 0.f; v[e] = 0.f; } };
        auto ldstate = [&](int s, int k, float* a, float* v) {
#pragma unroll
            for (int e = 0; e < 8; ++e) { a[e] = cs[(size_t)(s * 2 + k) * NUP + j0 + e]; v[e] = cs[(size_t)(s * 2 + k) * NUP + DFF + j0 + e]; } };
        ldrow((size_t)r, ca, cv);
        if (r < NTP) {
            const int t = r & 4095;
            if (t >= 1) ldrow((size_t)r - 1, h1a, h1v); else zero(h1a, h1v);
            if (t >= 2) ldrow((size_t)r - 2, h2a, h2v); else zero(h2a, h2v);
        } else {
            const int s = (r - NTP) >> 2, i = (r - NTP) & 3;
            if (i >= 1) ldrow((size_t)r - 1, h1a, h1v); else ldstate(s, 1, h1a, h1v);
            if (i >= 2) ldrow((size_t)r - 2, h2a, h2v); else ldstate(s, i, h2a, h2v);
        }
        unsigned ow[4];
#pragma unroll
        for (int e = 0; e < 8; e += 2) {
            float o[2];
#pragma unroll
            for (int k = 0; k < 2; ++k) {
                const int jj = j0 + e + k;
                const float a = bc[jj] + wc[jj] * h2a[e + k] + wc[NUP + jj] * h1a[e + k] + wc[2 * NUP + jj] * ca[e + k];
                const float v = bc[DFF + jj] + wc[DFF + jj] * h2v[e + k] + wc[NUP + DFF + jj] * h1v[e + k] + wc[2 * NUP + DFF + jj] * cv[e + k];
                o[k] = siluf(a) * v;
            }
            ow[e >> 1] = pk_bf16(o[0], o[1]);
        }
        *(u32x4*)(act + (size_t)r * DFF + j0) = (u32x4){ow[0], ow[1], ow[2], ow[3]};
    }
}

__device__ __forceinline__ void phase_final(const Params& p) {
    const float* gf = p.in[17];
    const int tid = threadIdx.x, wave = tid >> 6, lane = tid & 63;
    for (int row = blockIdx.x * 8 + wave; row < NTOK; row += gridDim.x * 8) {
        float* yr = row < NTP ? p.out + O_YP + (size_t)row * DM : p.out + O_YS + (size_t)(row - NTP) * DM;
        f32x4 v[8]; float s = 0.f;
#pragma unroll
        for (int q = 0; q < 8; ++q) { v[q] = *(const f32x4*)(yr + (q * 64 + lane) * 4); s += v[q][0] * v[q][0] + v[q][1] * v[q][1] + v[q][2] * v[q][2] + v[q][3] * v[q][3]; }
#pragma unroll
        for (int o = 32; o >= 1; o >>= 1) s += __shfl_xor(s, o);
        const float rs = rsqrtf(s * (1.0f / DM) + EPS);
#pragma unroll
        for (int q = 0; q < 8; ++q) {
            const int c = (q * 64 + lane) * 4;
            *(f32x4*)(yr + c) = v[q] * rs * *(const f32x4*)(gf + c);
        }
    }
}

constexpr int NPHASE = 10;
constexpr int NC_IN = 16, NC_OUT = 80, NC_UP = 16;
__global__ void __launch_bounds__(512, 2) fwd_kernel(Params p) {
    extern __shared__ __attribute__((aligned(16))) unsigned char smem[];
    unsigned char* ws = p.ws;
    const int lo = p.ph_lo, hi = p.ph_hi;
    volatile LAS unsigned* xst = (volatile LAS unsigned*)(LAS unsigned char*)(smem + LDS_BYTES - 32);
    if (threadIdx.x == 0) { xst[0] = 0u; xst[1] = 0u; }
    __syncthreads();
    (void)xcd_barrier_post((unsigned*)(ws + W_BAR), xst);
#define PH_BEGIN(k) if (lo <= (k) && (k) < hi) { if ((k) > lo) { if ((k) == 1 && p.ph_hi > NPHASE) cg::this_grid().sync(); else { XcdBarrier xb_; xb_.bar = (unsigned*)(p.ws + W_BAR); xb_.x = xb_xcc_id(); xb_.st = (volatile LAS unsigned*)(LAS unsigned char*)(smem + LDS_BYTES - 32); xcd_barrier(xb_); } }
#define PH_END }
    PH_BEGIN(0) phase_prep(p, smem); PH_END
    PH_BEGIN(1) {
        pg8::StaticOrder S;
        pg8::Gemm g{(const bf16_t*)(ws + W_XB), (const bf16_t*)(ws + W_WIN), MPAD, NIN, DM};
        const int ng = (int)gridDim.x - NC_IN;
        if ((int)blockIdx.x >= ng) copy_worker(p, smem, 0, ng);
        else {
            S.init(MPAD, NIN, DM, ng, blockIdx.x);
            EpiIn E{(bf16_t*)(ws + W_PROJ), (const float*)(ws + W_RSTD1), (float*)(ws + W_ZA), p.out, (bf16_t*)(ws + W_KC), (bf16_t*)(ws + W_VC)};
            pg8::gemm_phase(((LAS unsigned char*)smem), g, S, E);
            gemm_done(p, 0);
        }
    } PH_END
    PH_BEGIN(2) phase_mix(p, smem); PH_END
    PH_BEGIN(4) phase_combine(p); PH_END
    PH_BEGIN(5) {
        pg8::StaticOrder S;
        pg8::Gemm g{(const bf16_t*)(ws + W_MIX), (const bf16_t*)(ws + W_WOUT), MPAD, DM, DM};
        const int ng = (int)gridDim.x - NC_OUT;
        if ((int)blockIdx.x >= ng) copy_worker(p, smem, 1, ng);
        else {
            S.init(MPAD, DM, DM, ng, blockIdx.x);
            EpiOut E{p.in[0], p.in[1], (float*)(ws + W_H), (bf16_t*)(ws + W_HB), (float*)(ws + W_SS2)};
            pg8::gemm_phase(((LAS unsigned char*)smem), g, S, E);
            gemm_done(p, 1);
        }
    } PH_END
    PH_BEGIN(6) {
        pg8::StaticOrder S;
        pg8::Gemm g{(const bf16_t*)(ws + W_HB), (const bf16_t*)(ws + W_WUP), MPAD, NUP, DM};
        const int ng = (int)gridDim.x - NC_UP;
        if ((int)blockIdx.x >= ng) copy_worker(p, smem, 2, ng);
        else {
            S.init(MPAD, NUP, DM, ng, blockIdx.x);
            EpiUp E{(bf16_t*)(ws + W_U), (bf16_t*)(ws + W_ACT), (const float*)(ws + W_SS2), p.out, p.in[14], p.in[15]};
            pg8::gemm_phase(((LAS unsigned char*)smem), g, S, E);
            gemm_done(p, 2);
        }
    } PH_END
    PH_BEGIN(7) phase_convgate(p); PH_END
    PH_BEGIN(8) {
        pg8::StaticOrder S;
        pg8::Gemm g{(const bf16_t*)(ws + W_ACT), (const bf16_t*)(ws + W_WDOWN), MPAD, DM, DFF};
        S.init(MPAD, DM, DFF, gridDim.x, blockIdx.x, 22);
        EpiDown E{(const float*)(ws + W_H), p.out};
        pg8::gemm_phase<EpiDown, true>(((LAS unsigned char*)smem), g, S, E);
    } PH_END
    PH_BEGIN(9) copy_worker(p, smem, 0, 0); phase_final(p); PH_END
}

extern "C" void kernel_launch(void* const* d_in, const int* in_sizes, int n_in, void* d_out, int out_size, void* d_ws, size_t ws_size, hipStream_t stream) {
    static int grid = 0;
    if (grid == 0) {
        if (n_in != 18 || (size_t)out_size != O_END || ws_size < W_END) { fprintf(stderr, "kernel_launch: unexpected sizes n_in %d out %d ws %zu (need %zu)\n", n_in, out_size, ws_size, (size_t)W_END); grid = -1; return; }
        int dev = 0, cus = 0, per_cu = 0;
        hipGetDevice(&dev);
        hipDeviceGetAttribute(&cus, hipDeviceAttributeMultiprocessorCount, dev);
        if (hipFuncSetAttribute((const void*)fwd_kernel, hipFuncAttributeMaxDynamicSharedMemorySize, LDS_BYTES) != hipSuccess) { fprintf(stderr, "kernel_launch: hipFuncSetAttribute failed\n"); grid = -1; return; }
        if (hipOccupancyMaxActiveBlocksPerMultiprocessor(&per_cu, (const void*)fwd_kernel, NTHR, LDS_BYTES) != hipSuccess || per_cu < 1) { fprintf(stderr, "kernel_launch: occupancy query gave %d\n", per_cu); per_cu = 1; }
        (void)hipGetLastError();
        grid = cus * 1;
        if (grid <= 0) grid = 256;
    }
    if (grid < 0) return;
    Params p{};
    for (int i = 0; i < 18; ++i) p.in[i] = (const float*)d_in[i];
    p.out = (float*)d_out; p.ws = (unsigned char*)d_ws;
#if ONE_LAUNCH
    if (hipMemsetAsync((char*)d_ws + W_BAR, 0, 16384, stream) != hipSuccess) { fprintf(stderr, "kernel_launch: memset of the barrier words failed\n"); return; }
    p.ph_lo = 0; p.ph_hi = NPHASE;
    void* args[] = {&p};
    hipError_t e = hipLaunchCooperativeKernel((const void*)fwd_kernel, dim3(grid), dim3(NTHR), args, LDS_BYTES, stream);
    if (e != hipSuccess) fprintf(stderr, "cooperative launch failed: %s (grid %d)\n", hipGetErrorString(e), grid);
#else
    for (int ph = 0; ph < NPHASE; ++ph) {
        p.ph_lo = ph; p.ph_hi = ph + 1;
        hipLaunchKernelGGL(fwd_kernel, dim3(grid), dim3(NTHR), LDS_BYTES, stream, p);
    }
#endif
}
```
